# Optimizing an MI355X kernel written in HIP

```python
import jax, jax.numpy as jnp
from jax import lax
import numpy as np

D_MODEL = 2048
BATCH = 4
SEQ = 2048
DEPTH = 2

N_A_LAYERS = DEPTH // 2
N_B_LAYERS = DEPTH - N_A_LAYERS
EXPAND = 2
D_INNER = EXPAND * D_MODEL

HG_KEY_DIM = 128
HG_HEADS = D_MODEL // HG_KEY_DIM
HG_KEY_TOTAL = HG_HEADS * HG_KEY_DIM
HG_VAL_DIM = D_INNER // HG_HEADS
HG_CHUNK = 64

MLA_HEADS = 32
Q_LORA = 768
KV_LORA = 512
NOPE_DIM = 128
ROPE_DIM = 64
V_DIM = 128
ATTN_BLOCK = 128
ROPE_THETA = 10000.0
EPS = 1e-6

kernel_name = "yoco_hgrn2_mla_hybrid"


def rmsnorm(x, g):
    xf = x.astype(jnp.float32)
    y = xf * lax.rsqrt(jnp.mean(xf * xf, axis=-1, keepdims=True) + EPS)
    return (y * g.astype(jnp.float32)).astype(x.dtype)


def rope_tables(seq):
    pos = jnp.arange(seq, dtype=jnp.float32)
    inv_freq = ROPE_THETA ** (-jnp.arange(0, ROPE_DIM, 2, dtype=jnp.float32) / ROPE_DIM)
    ang = pos[:, None] * inv_freq[None, :]
    return jnp.cos(ang), jnp.sin(ang)


def apply_rope(x, cos, sin):
    xf = x.astype(jnp.float32)
    x1, x2 = jnp.split(xf, 2, axis=-1)
    out = jnp.concatenate([x1 * cos - x2 * sin, x2 * cos + x1 * sin], axis=-1)
    return out.astype(x.dtype)


def hgrn2_mixer(h, w_in, g_norm, w_out, lb):
    B, S, _ = h.shape
    proj = h @ w_in
    q, f, i, g = jnp.split(proj, [HG_KEY_TOTAL, 2 * HG_KEY_TOTAL, 2 * HG_KEY_TOTAL + D_INNER], axis=-1)
    ff = f.astype(jnp.float32)
    lb = lb.astype(jnp.float32)
    log_f = jnp.log(lb + (1.0 - lb) * jax.nn.sigmoid(ff))
    k = (1.0 - lb) * jax.nn.sigmoid(-ff)
    nc = S // HG_CHUNK

    def to_chunks(t, d):
        return t.astype(jnp.float32).reshape(B, nc, HG_CHUNK, HG_HEADS, d).transpose(1, 0, 3, 2, 4)

    qc, kc, gc = to_chunks(q, HG_KEY_DIM), to_chunks(k, HG_KEY_DIM), to_chunks(log_f, HG_KEY_DIM)
    vc = to_chunks(i, HG_VAL_DIM)
    causal = jnp.tril(jnp.ones((HG_CHUNK, HG_CHUNK), dtype=bool))

    def step(state, inp):
        q_, k_, v_, g_ = inp
        b = jnp.cumsum(g_, axis=2)
        o_inter = jnp.einsum('bhck,bhkv->bhcv', q_ * jnp.exp(b), state)
        rel = b[:, :, :, None, :] - b[:, :, None, :, :]
        decay = jnp.exp(jnp.where(causal[None, None, :, :, None], rel, -jnp.inf))
        scores = jnp.einsum('bhtk,bhsk,bhtsk->bhts', q_, k_, decay)
        o_intra = jnp.einsum('bhts,bhsv->bhtv', scores, v_)
        b_last = b[:, :, -1:, :]
        new_state = jnp.exp(b_last[:, :, 0, :])[..., None] * state + \
            jnp.einsum('bhsk,bhsv->bhkv', k_ * jnp.exp(b_last - b), v_)
        return new_state, o_inter + o_intra

    state0 = jnp.zeros((B, HG_HEADS, HG_KEY_DIM, HG_VAL_DIM), jnp.float32)
    _, o = lax.scan(step, state0, (qc, kc, vc, gc))
    o = o.transpose(1, 0, 3, 2, 4).reshape(B, S, HG_HEADS, HG_VAL_DIM).astype(h.dtype)
    o = rmsnorm(o, g_norm).reshape(B, S, D_INNER)
    return (o * jax.nn.silu(g)) @ w_out


def shared_mla_kv(stream, kv_in_norm_g, w_kv_down, kv_norm_g, w_kv_up, cos, sin):
    B, S, _ = stream.shape
    ckv = rmsnorm(stream, kv_in_norm_g) @ w_kv_down
    c, k_rope = jnp.split(ckv, [KV_LORA], axis=-1)
    kv = (rmsnorm(c, kv_norm_g) @ w_kv_up).reshape(B, S, MLA_HEADS, NOPE_DIM + V_DIM)
    k_nope, v = jnp.split(kv, [NOPE_DIM], axis=-1)
    k_rope = apply_rope(k_rope, cos, sin)
    return k_nope, k_rope, v


def causal_mla_attention(q_nope, q_rope, k_nope, k_rope, v):
    B, S, H, _ = q_nope.shape
    nb = S // ATTN_BLOCK
    scale = (NOPE_DIM + ROPE_DIM) ** -0.5
    key_pos = jnp.arange(S)

    def to_blocks(t):
        return t.reshape(B, nb, ATTN_BLOCK, *t.shape[2:]).swapaxes(0, 1)

    def one_block(args):
        qn, qr, start = args
        s = jnp.einsum('bqhd,bkhd->bhqk', qn, k_nope) + jnp.einsum('bqhr,bkr->bhqk', qr, k_rope)
        s = s.astype(jnp.float32) * scale
        q_pos = start + jnp.arange(ATTN_BLOCK)
        s = jnp.where(key_pos[None, :] <= q_pos[:, None], s, -jnp.inf)
        p = jax.nn.softmax(s, axis=-1).astype(v.dtype)
        return jnp.einsum('bhqk,bkhd->bqhd', p, v)

    starts = jnp.arange(nb, dtype=jnp.int32) * ATTN_BLOCK
    out = lax.map(one_block, (to_blocks(q_nope), to_blocks(q_rope), starts))
    return out.swapaxes(0, 1).reshape(B, S, H, V_DIM)


def mla_query_mixer(h, w_in, q_norm_g, w_q_up, w_out, k_nope, k_rope, v, cos, sin):
    B, S, _ = h.shape
    cq, gate = jnp.split(h @ w_in, [Q_LORA], axis=-1)
    q = (rmsnorm(cq, q_norm_g) @ w_q_up).reshape(B, S, MLA_HEADS, NOPE_DIM + ROPE_DIM)
    q_nope, q_rope = jnp.split(q, [NOPE_DIM], axis=-1)
    q_rope = apply_rope(q_rope, cos[:, None, :], sin[:, None, :])
    attn = causal_mla_attention(q_nope, q_rope, k_nope, k_rope, v).reshape(B, S, D_INNER)
    return (attn * jax.nn.silu(gate)) @ w_out


def setup_inputs(seed: int = 0) -> dict:
    key = jax.random.key(seed)
    ks = jax.random.split(key, 20)

    def w(k, shape, fan_in):
        return jax.random.normal(k, shape, jnp.float32) * fan_in ** -0.5

    def gain(k, shape):
        return 1.0 + 0.02 * jax.random.normal(k, shape, jnp.float32)

    hg_in_cols = 2 * HG_KEY_TOTAL + 2 * D_INNER
    return {
        "x": jax.random.normal(ks[0], (BATCH, SEQ, D_MODEL), jnp.float32),
        "norm_g": gain(ks[1], (DEPTH, D_MODEL)),
        "hg_w_in": w(ks[2], (N_A_LAYERS, D_MODEL, hg_in_cols), D_MODEL),
        "hg_g_norm": gain(ks[3], (N_A_LAYERS, HG_VAL_DIM)),
        "hg_w_out": w(ks[4], (N_A_LAYERS, D_INNER, D_MODEL), D_INNER),
        "hg_lb": 0.5 * jax.random.normal(ks[5], (DEPTH, HG_KEY_TOTAL), jnp.float32),
        "kv_in_norm_g": gain(ks[6], (D_MODEL,)),
        "w_kv_down": w(ks[7], (D_MODEL, KV_LORA + ROPE_DIM), D_MODEL),
        "kv_norm_g": gain(ks[8], (KV_LORA,)),
        "w_kv_up": w(ks[9], (KV_LORA, MLA_HEADS * (NOPE_DIM + V_DIM)), KV_LORA),
        "mla_w_in": w(ks[10], (N_B_LAYERS, D_MODEL, Q_LORA + D_INNER), D_MODEL),
        "mla_q_norm_g": gain(ks[11], (N_B_LAYERS, Q_LORA)),
        "mla_w_q_up": w(ks[12], (N_B_LAYERS, Q_LORA, MLA_HEADS * (NOPE_DIM + ROPE_DIM)), Q_LORA),
        "mla_w_out": w(ks[13], (N_B_LAYERS, D_INNER, D_MODEL), D_INNER),
        "final_norm_g": gain(ks[14], (D_MODEL,)),
    }


def reference(x, norm_g, hg_w_in, hg_g_norm, hg_w_out, hg_lb, kv_in_norm_g, w_kv_down, kv_norm_g,
              w_kv_up, mla_w_in, mla_q_norm_g, mla_w_q_up, mla_w_out, final_norm_g):
    S = x.shape[1]
    cos, sin = rope_tables(S)
    lower_bounds = jnp.cumsum(jax.nn.softmax(hg_lb.astype(jnp.float32), axis=0), axis=0)
    h = x
    k_nope = k_rope = v = None
    for layer in range(DEPTH):
        if layer < N_A_LAYERS:
            h = h + hgrn2_mixer(rmsnorm(h, norm_g[layer]), hg_w_in[layer], hg_g_norm[layer],
                                hg_w_out[layer], lower_bounds[layer])
        else:
            j = layer - N_A_LAYERS
            if j == 0:
                k_nope, k_rope, v = shared_mla_kv(h, kv_in_norm_g, w_kv_down, kv_norm_g, w_kv_up, cos, sin)
            h = h + mla_query_mixer(rmsnorm(h, norm_g[layer]), mla_w_in[j], mla_q_norm_g[j],
                                    mla_w_q_up[j], mla_w_out[j], k_nope, k_rope, v, cos, sin)
    return rmsnorm(h, final_norm_g)
```

```cpp
#include <hip/hip_runtime.h>
#include <hip/hip_cooperative_groups.h>
#include <cstdio>
#include <cstdint>
namespace cg = cooperative_groups;
namespace pg8 {
#define PG8_LAS __attribute__((address_space(3)))
typedef unsigned short bf16_t;
typedef short bf16x8 __attribute__((ext_vector_type(8)));
typedef float f32x4 __attribute__((ext_vector_type(4)));
typedef unsigned u32x4 __attribute__((ext_vector_type(4)));
constexpr int BM = 256, BK = 64, HALF = 128, HTB = HALF * BK * 2  , STAGE_BYTES = 8 * HTB, NXCD = 8, WGM = 8;

__host__ __device__ __forceinline__ int lds_byte(int r, int c) { const int st = (r >> 4) * 2 + (c >> 5), rr = r & 15, cc = c & 31, ob = rr * 64 + cc * 2; return st * 1024 + (ob ^ (((ob >> 9) & 1) << 5)); }
__host__ __device__ __forceinline__ void stage_rc(int b, int& R, int& C) { const int st = b / 1024, sb = b % 1024, swz = sb ^ (((sb >> 9) & 1) << 5); R = (st >> 1) * 16 + swz / 64; C = (st & 1) * 32 + (swz % 64) / 2; }
__host__ __device__ __forceinline__ int perm32(int rho) { const int n = rho >> 4, i = rho & 15; return 8 * (i >> 2) + 4 * n + (i & 3); }

struct Unit { int pm, pn; };
struct Gemm { const bf16_t* A; const bf16_t* Bt; int M, N, K; };

struct StaticOrder {
    int nM, nN, nwg, G, c;
    __host__ __device__ void init(int M, int N, int G_, int c_) { nM = M / BM; nN = N / BM; nwg = nM * nN; G = G_; c = c_; }
    __host__ __device__ bool next(int i, Unit& u) const {
        const long L = (long)i * G + c; if (L >= nwg) return false;
        int wgid = (int)L; { const int q = nwg / NXCD, r = nwg % NXCD, xcd = wgid % NXCD, off = wgid / NXCD; wgid = (xcd < r ? xcd * (q + 1) : r * (q + 1) + (xcd - r) * q) + off; }
        const int nig = WGM * nN, gid = wgid / nig, fm = gid * WGM, gsz = (nM - fm) < WGM ? (nM - fm) : WGM;
        u.pm = fm + ((wgid % nig) % gsz); u.pn = (wgid % nig) / gsz; return true;
    }
    __device__ __forceinline__ void a_ready(const Unit&) const {}
    __device__ __forceinline__ void done(const Unit&) const {}
};

__device__ __forceinline__ unsigned cvt_pk_bf16(float lo, float hi) { unsigned r; asm volatile("v_cvt_pk_bf16_f32 %0, %1, %2" : "=v"(r) : "v"(lo), "v"(hi)); return r; }
template <class Epi, class Sched, bool ALIGN_EPI = false, bool SP2 = false>
__device__ __forceinline__ void gemm_phase(PG8_LAS unsigned char* lds, const Gemm g, const Sched& S, const Epi& E) {
    const int tid = threadIdx.x, wid = __builtin_amdgcn_readfirstlane(tid >> 6), lane = tid & 63, wr = wid >> 2, wc = wid & 3, fr = lane & 15, fq = lane >> 4;
    const int K = g.K, nt = K / BK;
    unsigned voffA[2], voffB[2];
#pragma unroll
    for (int i = 0; i < 2; ++i) { int R, C; stage_rc(tid * 16 + i * 8192, R, C); const int Rb = Epi::PERM ? ((R & ~31) + perm32(R & 31)) : R;
        voffA[i] = (unsigned)(R * K + C) * 2u; voffB[i] = (unsigned)(Rb * K + C) * 2u; }
    const size_t kstep = (size_t)(BK * 2);
    const size_t hstep = (size_t)HALF * K * 2;
    const size_t tstep = 2 * hstep;
    const unsigned ldsw = (unsigned)wid * 1024u;
    const int aoff = lds_byte(wr * 64 + fr, fq * 8), boff = lds_byte(wc * 32 + fr, fq * 8);
#define PG8_SA(b, h) (((b) * 2 + (h)) * HTB)
#define PG8_SB(b, h) ((4 + (b) * 2 + (h)) * HTB)
#define PG8_STAGE(bufoff, gbase, voff) do { _Pragma("unroll") for (int _i = 0; _i < 2; ++_i) \
        __builtin_amdgcn_global_load_lds((const unsigned*)((const char*)(gbase) + (voff)[_i]), (PG8_LAS unsigned*)(lds + (bufoff) + ldsw + _i * 8192), 16, 0, 0); } while (0)
#define PG8_LDA(dst, b, h) do { _Pragma("unroll") for (int m = 0; m < 4; ++m) _Pragma("unroll") for (int k = 0; k < 2; ++k) dst[m][k] = *(const PG8_LAS bf16x8*)(lds + PG8_SA(b, h) + aoff + m * 2048 + k * 1024); } while (0)
#define PG8_LDB(dst, b, h) do { _Pragma("unroll") for (int n = 0; n < 2; ++n) _Pragma("unroll") for (int k = 0; k < 2; ++k) dst[n][k] = *(const PG8_LAS bf16x8*)(lds + PG8_SB(b, h) + boff + n * 2048 + k * 1024); } while (0)
#define PG8_MMA(ai, bj, At, Bt) do { __builtin_amdgcn_s_setprio(1); _Pragma("unroll") for (int m = 0; m < 4; ++m) _Pragma("unroll") for (int n = 0; n < 2; ++n) _Pragma("unroll") for (int k = 0; k < 2; ++k) \
        acc[ai][bj][m][n] = __builtin_amdgcn_mfma_f32_16x16x32_bf16(Bt[n][k], At[m][k], acc[ai][bj][m][n], 0, 0, 0); __builtin_amdgcn_s_setprio(0); } while (0)
#define PG8_WAIT_V(n) asm volatile("s_waitcnt vmcnt(" #n ")" ::: "memory")
#define PG8_WAIT_L(n) asm volatile("s_waitcnt lgkmcnt(" #n ")" ::: "memory")
#define PG8_BAR __builtin_amdgcn_s_barrier()
#define PG8_SCHED __builtin_amdgcn_sched_barrier(0)
    Unit cur, nxt; int ui = 0;
    if (!S.next(0, cur)) return;
    f32x4 acc[2][2][4][2];
#pragma unroll
    for (int a = 0; a < 2; ++a)
#pragma unroll
        for (int b = 0; b < 2; ++b)
#pragma unroll
            for (int m = 0; m < 4; ++m)
#pragma unroll
                for (int n = 0; n < 2; ++n) acc[a][b][m][n] = (f32x4){0.f, 0.f, 0.f, 0.f};
    bf16x8 At[4][2], B0[2][2], B1[2][2];
    const char* cA = (const char*)g.A + (size_t)cur.pm * tstep; const char* cB = (const char*)g.Bt + (size_t)cur.pn * tstep;
    S.a_ready(cur);
    if constexpr (SP2) {
        PG8_STAGE(PG8_SB(0, 0), cB, voffB); PG8_STAGE(PG8_SB(0, 1), cB + hstep, voffB); PG8_STAGE(PG8_SA(0, 0), cA, voffA); PG8_STAGE(PG8_SA(0, 1), cA + hstep, voffA);
        if (wr == 1) PG8_BAR;
        PG8_WAIT_V(2); PG8_BAR;
        PG8_STAGE(PG8_SB(1, 0), cB + kstep, voffB); PG8_STAGE(PG8_SA(1, 0), cA + kstep, voffA); PG8_STAGE(PG8_SB(1, 1), cB + hstep + kstep, voffB);
        PG8_WAIT_V(6); PG8_BAR;
    } else {
        PG8_STAGE(PG8_SB(0, 0), cB, voffB); PG8_STAGE(PG8_SA(0, 0), cA, voffA); PG8_STAGE(PG8_SB(0, 1), cB + hstep, voffB); PG8_STAGE(PG8_SA(0, 1), cA + hstep, voffA);
        if (wr == 1) PG8_BAR;
        PG8_WAIT_V(4); PG8_BAR;
        PG8_STAGE(PG8_SB(1, 0), cB + kstep, voffB); PG8_STAGE(PG8_SA(1, 0), cA + kstep, voffA); PG8_STAGE(PG8_SB(1, 1), cB + hstep + kstep, voffB);
        PG8_WAIT_V(6); PG8_BAR;
    }
    for (;;) {
        const bool has_next = S.next(ui + 1, nxt);
        const char* nA = has_next ? (const char*)g.A + (size_t)nxt.pm * tstep : cA; const char* nB = has_next ? (const char*)g.Bt + (size_t)nxt.pn * tstep : cB;
        for (int t = 0; t < nt; t += 2) {
            const bool last = (t == nt - 2);
            const char* a1 = cA + (size_t)(t + 1) * kstep;
            const char* a2 = last ? nA : cA + (size_t)(t + 2) * kstep; const char* b2 = last ? nB : cB + (size_t)(t + 2) * kstep;
            const char* a3 = a2 + kstep; const char* b3 = b2 + kstep;
            if (last && has_next) S.a_ready(nxt);
            if constexpr (SP2) {
            PG8_LDB(B0, 0, 0); PG8_LDB(B1, 0, 1); PG8_SCHED; PG8_LDA(At, 0, 0); PG8_STAGE(PG8_SA(1, 1), a1 + hstep, voffA);
            PG8_WAIT_V(8); PG8_WAIT_L(0); PG8_BAR; PG8_MMA(0, 0, At, B0); PG8_MMA(0, 1, At, B1); PG8_BAR; PG8_SCHED;
            PG8_LDA(At, 0, 1); PG8_STAGE(PG8_SB(0, 0), b2, voffB); PG8_STAGE(PG8_SB(0, 1), b2 + hstep, voffB); PG8_STAGE(PG8_SA(0, 0), a2, voffA);
            PG8_WAIT_V(8); PG8_WAIT_L(0); PG8_BAR; PG8_MMA(1, 0, At, B0); PG8_MMA(1, 1, At, B1); PG8_BAR; PG8_SCHED;
            PG8_LDB(B0, 1, 0); PG8_LDB(B1, 1, 1); PG8_SCHED; PG8_LDA(At, 1, 0); PG8_STAGE(PG8_SA(0, 1), a2 + hstep, voffA);
            PG8_WAIT_V(8); PG8_WAIT_L(0); PG8_BAR; PG8_MMA(0, 0, At, B0); PG8_MMA(0, 1, At, B1); PG8_BAR; PG8_SCHED;
            PG8_LDA(At, 1, 1); PG8_STAGE(PG8_SB(1, 0), b3, voffB); PG8_STAGE(PG8_SB(1, 1), b3 + hstep, voffB); PG8_STAGE(PG8_SA(1, 0), a3, voffA);
            PG8_WAIT_V(8); PG8_WAIT_L(0); PG8_BAR; PG8_MMA(1, 0, At, B0); PG8_MMA(1, 1, At, B1); PG8_BAR; PG8_SCHED;
            } else {
            PG8_LDB(B0, 0, 0); PG8_SCHED; PG8_LDA(At, 0, 0); PG8_STAGE(PG8_SA(1, 1), a1 + hstep, voffA);
            PG8_WAIT_L(8); PG8_BAR; PG8_WAIT_L(0); PG8_MMA(0, 0, At, B0); PG8_BAR; PG8_SCHED;
            PG8_LDB(B1, 0, 1); PG8_STAGE(PG8_SB(0, 0), b2, voffB);
            PG8_BAR; PG8_WAIT_L(0); PG8_MMA(0, 1, At, B1); PG8_BAR;
            PG8_LDA(At, 0, 1); PG8_STAGE(PG8_SA(0, 0), a2, voffA);
            PG8_BAR; PG8_WAIT_L(0); PG8_MMA(1, 0, At, B0); PG8_BAR; PG8_SCHED;
            PG8_STAGE(PG8_SB(0, 1), b2 + hstep, voffB);
            PG8_WAIT_V(6); PG8_BAR; PG8_MMA(1, 1, At, B1); PG8_BAR;
            PG8_LDB(B0, 1, 0); PG8_SCHED; PG8_LDA(At, 1, 0); PG8_STAGE(PG8_SA(0, 1), a2 + hstep, voffA);
            PG8_WAIT_L(8); PG8_BAR; PG8_WAIT_L(0); PG8_MMA(0, 0, At, B0); PG8_BAR; PG8_SCHED;
            PG8_LDB(B1, 1, 1); PG8_STAGE(PG8_SB(1, 0), b3, voffB);
            PG8_BAR; PG8_WAIT_L(0); PG8_MMA(0, 1, At, B1); PG8_BAR;
            PG8_LDA(At, 1, 1); PG8_STAGE(PG8_SA(1, 0), a3, voffA);
            PG8_BAR; PG8_WAIT_L(0); PG8_MMA(1, 0, At, B0); PG8_BAR; PG8_SCHED;
            PG8_STAGE(PG8_SB(1, 1), b3 + hstep, voffB);
            PG8_WAIT_V(6); PG8_BAR; PG8_MMA(1, 1, At, B1); PG8_BAR;
            }
        }
        if constexpr (ALIGN_EPI) { if (wr == 0) PG8_BAR; }
        if constexpr (!Epi::AFTER_DRAIN) { E(acc, cur, wr, wc, fr, fq); S.done(cur); }
        if (!has_next) break;
#pragma unroll
        for (int a = 0; a < 2; ++a)
#pragma unroll
            for (int b = 0; b < 2; ++b)
#pragma unroll
                for (int m = 0; m < 4; ++m)
#pragma unroll
                    for (int n = 0; n < 2; ++n) acc[a][b][m][n] = (f32x4){0.f, 0.f, 0.f, 0.f};
        cur = nxt; cA = nA; cB = nB; ++ui;
        if constexpr (ALIGN_EPI) { if (wr == 1) PG8_BAR; }
    }
    PG8_WAIT_V(0);
    if constexpr (!ALIGN_EPI) { if (wr == 0) PG8_BAR; }
    PG8_BAR;
    if constexpr (Epi::AFTER_DRAIN) { E.fused(acc, cur, wr, wc, fr, fq, lds, wid, lane); S.done(cur); }
#undef PG8_SA
#undef PG8_SB
#undef PG8_STAGE
#undef PG8_LDA
#undef PG8_LDB
#undef PG8_MMA
#undef PG8_WAIT_V
#undef PG8_WAIT_L
#undef PG8_BAR
#undef PG8_SCHED
}
}
#define PG8_ALIGN true
#define PG8_SP2 true
#define LAS __attribute__((address_space(3)))
typedef unsigned short bf16_t;
typedef float f32x4 __attribute__((ext_vector_type(4)));
typedef unsigned u32x4 __attribute__((ext_vector_type(4)));
typedef unsigned u32x2 __attribute__((ext_vector_type(2)));
using pg8::cvt_pk_bf16;
constexpr int NTOK = 8192, DM = 2048, SEQ = 2048, DI = 4096;
constexpr float EPS = 1e-6f;
constexpr size_t MiB = 1u << 20;
constexpr size_t WS_W2T = 1 * MiB, WS_W3T = 17 * MiB, WS_W4T = 39 * MiB, WS_W5T = 48 * MiB, WS_W6T = 56 * MiB;
constexpr size_t WS_QH = 72 * MiB, WS_VI = 104 * MiB, WS_GS = 168 * MiB, WS_ST = 232 * MiB, WS_W1T = 232 * MiB, WS_XN = 280 * MiB;
constexpr size_t WS_H1B = 72 * MiB, WS_Q = 72 * MiB, WS_KN = 168 * MiB, WS_GATE = 232 * MiB, WS_CQ = 296 * MiB, WS_C = 308 * MiB, WS_KR = 316 * MiB, WS_V = 317 * MiB;
constexpr size_t WS_SS1 = 381 * MiB, WS_SSQ = 382 * MiB, WS_SSC = 382 * MiB + 512 * 1024, WS_SS2 = 383 * MiB, WS_NEED = 384 * MiB;
constexpr int LDS_BYTES = 147456;
constexpr float QSCALE = 0.07216878364870322f * 1.4426950408889634f;

struct Params {
    const float* x; const float* norm_g; const float* hg_w_in; const float* hg_g_norm; const float* hg_w_out; const float* hg_lb;
    const float* kv_in_norm_g; const float* w_kv_down; const float* kv_norm_g; const float* w_kv_up; const float* mla_w_in; const float* mla_q_norm_g;
    const float* mla_w_q_up; const float* mla_w_out; const float* final_norm_g;
    float* out; unsigned char* ws;
};

__device__ __forceinline__ float bf2f(bf16_t v) { return __uint_as_float((unsigned)v << 16); }
__device__ __forceinline__ float bflo(unsigned u) { return __uint_as_float(u << 16); }
__device__ __forceinline__ float bfhi(unsigned u) { return __uint_as_float(u & 0xffff0000u); }
__device__ __forceinline__ float silu_f(float v) { return v * __builtin_amdgcn_rcpf(1.0f + __builtin_amdgcn_exp2f(-1.4426950408889634f * v)); }
__device__ __forceinline__ float wave_sum(float v) {
#pragma unroll
    for (int o = 1; o < 64; o <<= 1) v += __shfl_xor(v, o);
    return v;
}
__device__ __forceinline__ void store8_bf16(bf16_t* p, const f32x4& a, const f32x4& b) {
    u32x4 w; w.x = cvt_pk_bf16(a[0], a[1]); w.y = cvt_pk_bf16(a[2], a[3]); w.z = cvt_pk_bf16(b[0], b[1]); w.w = cvt_pk_bf16(b[2], b[3]);
    *(u32x4*)p = w;
}
__device__ __forceinline__ void rope8(f32x4& a, f32x4& b, int pos, int j0) {
    float v[8] = {a[0], a[1], a[2], a[3], b[0], b[1], b[2], b[3]};
#pragma unroll
    for (int p = 0; p < 4; ++p) {
        const float inv = __builtin_amdgcn_exp2f(-(float)(j0 + p) * 0.41524101186092029f);
        float rev = (float)pos * inv * 0.15915494309189535f; rev = rev - floorf(rev);
        const float c = __builtin_amdgcn_cosf(rev), s = __builtin_amdgcn_sinf(rev);
        const float x1 = v[2 * p], x2 = v[2 * p + 1];
        v[2 * p] = x1 * c - x2 * s; v[2 * p + 1] = x2 * c + x1 * s;
    }
    a = (f32x4){v[0], v[1], v[2], v[3]}; b = (f32x4){v[4], v[5], v[6], v[7]};
}

typedef const f32x4 (&AccRef)[2][2][4][2];
struct EpiG1 {
    static constexpr bool PERM = true, AFTER_DRAIN = false;
    bf16_t* Qh; float* F; bf16_t* VI; bf16_t* GS;
    __device__ __forceinline__ void operator()(AccRef acc, const pg8::Unit& u, int wr, int wc, int fr, int fq) const {
        const int pn = u.pn;
#pragma unroll
        for (int ai = 0; ai < 2; ++ai)
#pragma unroll
            for (int m = 0; m < 4; ++m) {
                const size_t row = (size_t)(u.pm * 256 + ai * 128 + wr * 64 + m * 16 + fr);
#pragma unroll
                for (int bj = 0; bj < 2; ++bj) {
                    const int col = pn * 256 + bj * 128 + wc * 32 + 8 * fq;
                    f32x4 a = acc[ai][bj][m][0], b = acc[ai][bj][m][1];
                    if (pn < 8) store8_bf16(Qh + row * 2048 + col, a, b);
                    else if (pn < 16) { float* o = F + row * 2048 + (col - 2048); *(f32x4*)o = a; *(f32x4*)(o + 4) = b; }
                    else if (pn < 32) store8_bf16(VI + row * 4096 + (col - 4096), a, b);
                    else {
#pragma unroll
                        for (int j = 0; j < 4; ++j) { a[j] = silu_f(a[j]); b[j] = silu_f(b[j]); }
                        store8_bf16(GS + row * 4096 + (col - 8192), a, b);
                    }
                }
            }
    }
};
template <bool WB> struct EpiRes {
    static constexpr bool PERM = true, AFTER_DRAIN = false;
    const float* base; float* out; bf16_t* outb; float* ss;
    __device__ __forceinline__ void operator()(AccRef acc, const pg8::Unit& u, int wr, int wc, int fr, int fq) const {
#pragma unroll
        for (int ai = 0; ai < 2; ++ai)
#pragma unroll
            for (int m = 0; m < 4; ++m) {
                const size_t row = (size_t)(u.pm * 256 + ai * 128 + wr * 64 + m * 16 + fr);
                float s = 0.f;
#pragma unroll
                for (int bj = 0; bj < 2; ++bj) {
                    const int col = u.pn * 256 + bj * 128 + wc * 32 + 8 * fq;
                    const size_t off = row * 2048 + col;
                    f32x4 a = acc[ai][bj][m][0] + *(const f32x4*)(base + off), b = acc[ai][bj][m][1] + *(const f32x4*)(base + off + 4);
                    *(f32x4*)(out + off) = a; *(f32x4*)(out + off + 4) = b;
                    if (WB) store8_bf16(outb + off, a, b);
                    s += (a[0] * a[0] + a[1] * a[1]) + (a[2] * a[2] + a[3] * a[3]) + (b[0] * b[0] + b[1] * b[1]) + (b[2] * b[2] + b[3] * b[3]);
                }
                s += __shfl_xor(s, 16); s += __shfl_xor(s, 32);
                if (fq == 0) ss[row * 32 + u.pn * 4 + wc] = s;
            }
    }
};
struct EpiG3 {
    static constexpr bool PERM = true, AFTER_DRAIN = false;
    const float* ss1; bf16_t* CQ; bf16_t* GATE; bf16_t* C; bf16_t* KR; float* ssq; float* ssc;
    __device__ __forceinline__ void operator()(AccRef acc, const pg8::Unit& u, int wr, int wc, int fr, int fq) const {
        const int pn = u.pn;
#pragma unroll
        for (int ai = 0; ai < 2; ++ai)
#pragma unroll
            for (int m = 0; m < 4; ++m) {
                const size_t row = (size_t)(u.pm * 256 + ai * 128 + wr * 64 + m * 16 + fr);
                float t = 0.f;
                { const f32x4* sp = (const f32x4*)(ss1 + row * 32);
#pragma unroll
                  for (int i = 0; i < 8; ++i) { const f32x4 q = sp[i]; t += (q[0] + q[1]) + (q[2] + q[3]); } }
                const float rs = __builtin_amdgcn_rsqf(t * (1.0f / 2048.0f) + EPS);
                float s = 0.f;
#pragma unroll
                for (int bj = 0; bj < 2; ++bj) {
                    const int lc = bj * 128 + wc * 32 + 8 * fq;
                    f32x4 a = acc[ai][bj][m][0] * rs, b = acc[ai][bj][m][1] * rs;
                    if (pn < 3) { store8_bf16(CQ + row * 768 + pn * 256 + lc, a, b); }
                    else if (pn < 19) {
#pragma unroll
                        for (int j = 0; j < 4; ++j) { a[j] = silu_f(a[j]); b[j] = silu_f(b[j]); }
                        store8_bf16(GATE + row * 4096 + (pn - 3) * 256 + lc, a, b);
                    } else if (pn < 21) { store8_bf16(C + row * 512 + (pn - 19) * 256 + lc, a, b); }
                    else if (bj == 0 && wc < 2) { rope8(a, b, (int)(row & 2047), wc * 16 + 4 * fq); store8_bf16(KR + row * 64 + lc, a, b); }
                    s += (a[0] * a[0] + a[1] * a[1]) + (a[2] * a[2] + a[3] * a[3]) + (b[0] * b[0] + b[1] * b[1]) + (b[2] * b[2] + b[3] * b[3]);
                }
                s += __shfl_xor(s, 16); s += __shfl_xor(s, 32);
                if (fq == 0) { if (pn < 3) ssq[row * 16 + pn * 4 + wc] = s; else if (pn == 19 || pn == 20) ssc[row * 8 + (pn - 19) * 4 + wc] = s; }
            }
    }
};
struct EpiQ {
    static constexpr bool PERM = true, AFTER_DRAIN = false;
    const float* ssq; bf16_t* Q;
    __device__ __forceinline__ void operator()(AccRef acc, const pg8::Unit& u, int wr, int wc, int fr, int fq) const {
        const int pn = u.pn;
#pragma unroll
        for (int ai = 0; ai < 2; ++ai)
#pragma unroll
            for (int m = 0; m < 4; ++m) {
                const int row = u.pm * 256 + ai * 128 + wr * 64 + m * 16 + fr;
                const f32x4* sp = (const f32x4*)(ssq + (size_t)row * 16);
                const f32x4 q0 = sp[0], q1 = sp[1], q2 = sp[2];
                const float t = ((q0[0] + q0[1]) + (q0[2] + q0[3])) + ((q1[0] + q1[1]) + (q1[2] + q1[3])) + ((q2[0] + q2[1]) + (q2[2] + q2[3]));
                const float rs = __builtin_amdgcn_rsqf(t * (1.0f / 768.0f) + EPS) * QSCALE;
                const int b_ = row >> 11, s_ = row & 2047;
#pragma unroll
                for (int bj = 0; bj < 2; ++bj) {
                    f32x4 a = acc[ai][bj][m][0] * rs, b = acc[ai][bj][m][1] * rs;
                    if (pn < 16) { const int h = pn * 2 + bj; store8_bf16(Q + ((size_t)((b_ * 32 + h) * 2048 + s_)) * 192 + wc * 32 + 8 * fq, a, b); }
                    else { const int h = (pn - 16) * 4 + bj * 2 + (wc >> 1), off = (wc & 1) * 32 + 8 * fq;
                        rope8(a, b, s_, off >> 1); store8_bf16(Q + ((size_t)((b_ * 32 + h) * 2048 + s_)) * 192 + 128 + off, a, b); }
                }
            }
    }
};
struct EpiKV {
    static constexpr bool PERM = true, AFTER_DRAIN = false;
    const float* ssc; bf16_t* KN; bf16_t* V;
    __device__ __forceinline__ void operator()(AccRef acc, const pg8::Unit& u, int wr, int wc, int fr, int fq) const {
        const int h = u.pn;
#pragma unroll
        for (int ai = 0; ai < 2; ++ai)
#pragma unroll
            for (int m = 0; m < 4; ++m) {
                const int row = u.pm * 256 + ai * 128 + wr * 64 + m * 16 + fr;
                const f32x4* sp = (const f32x4*)(ssc + (size_t)row * 8);
                const f32x4 q0 = sp[0], q1 = sp[1];
                const float t = ((q0[0] + q0[1]) + (q0[2] + q0[3])) + ((q1[0] + q1[1]) + (q1[2] + q1[3]));
                const float rs = __builtin_amdgcn_rsqf(t * (1.0f / 512.0f) + EPS);
                const int b_ = row >> 11, s_ = row & 2047;
                const size_t o = ((size_t)((b_ * 32 + h) * 2048 + s_)) * 128 + wc * 32 + 8 * fq;
                store8_bf16(KN + o, acc[ai][0][m][0] * rs, acc[ai][0][m][1] * rs);
                store8_bf16(V + o, acc[ai][1][m][0] * rs, acc[ai][1][m][1] * rs);
            }
    }
};

template <int MODE> __device__ __forceinline__ int src_col(int n) {
    if (MODE == 0) return n;
    if (MODE == 1) { if (n < 512) return n; const int o = n - 512; return 512 + (o >> 1) + 32 * (o & 1); }
    if (n < 4096) return (n >> 7) * 192 + (n & 127);
    const int r = n - 4096, h = r >> 6, o = r & 63; return h * 192 + 128 + (o >> 1) + 32 * (o & 1);
}
template <int MODE> __device__ __forceinline__ void transpose_item(const float* __restrict__ W, int K, int Nsrc, int Nout, const float* __restrict__ gain, bf16_t* WT, int row_off, LAS float* scr, int item, int lane) {
    const int nblk = Nout / 32, kb = item / nblk, nb = item % nblk, k0 = 64 * kb, n0 = 32 * nb;
    const int sc = src_col<MODE>(n0 + (lane & 31));
#pragma unroll 8
    for (int i = 0; i < 32; ++i) { const int kk = 2 * i + (lane >> 5); const float g = gain ? gain[k0 + kk] : 1.0f; scr[kk * 33 + (lane & 31)] = W[(size_t)(k0 + kk) * Nsrc + sc] * g; }
    asm volatile("s_waitcnt lgkmcnt(0)" ::: "memory");
    const int c = lane & 7;
#pragma unroll
    for (int j = 0; j < 4; ++j) { const int n = (lane >> 3) + 8 * j; const LAS float* s = scr + (8 * c) * 33 + n;
        u32x4 o; o.x = cvt_pk_bf16(s[0 * 33], s[1 * 33]); o.y = cvt_pk_bf16(s[2 * 33], s[3 * 33]); o.z = cvt_pk_bf16(s[4 * 33], s[5 * 33]); o.w = cvt_pk_bf16(s[6 * 33], s[7 * 33]);
        *(u32x4*)(WT + (size_t)(row_off + n0 + n) * K + k0 + 8 * c) = o; }
    asm volatile("s_waitcnt lgkmcnt(0)" ::: "memory");
}
__device__ __forceinline__ void phase0(const Params& p, LAS unsigned char* lds, int wave, int lane, int gw, int NGW) {
    LAS float* scr = (LAS float*)(lds + wave * 16384);
    bf16_t* W1T = (bf16_t*)(p.ws + WS_W1T); bf16_t* W2T = (bf16_t*)(p.ws + WS_W2T); bf16_t* W3T = (bf16_t*)(p.ws + WS_W3T);
    bf16_t* W4T = (bf16_t*)(p.ws + WS_W4T); bf16_t* W5T = (bf16_t*)(p.ws + WS_W5T); bf16_t* W6T = (bf16_t*)(p.ws + WS_W6T);
    constexpr int I1 = 32 * 384, I2 = 64 * 64, I3a = 32 * 152, I3b = 32 * 18, I4 = 12 * 192, I5 = 8 * 256, I6 = 64 * 64;
    constexpr int NIT = I1 + I2 + I3a + I3b + I4 + I5 + I6;
    for (int it = gw; it < NIT; it += NGW) {
        int r = it;
        if (r < I1) { transpose_item<0>(p.hg_w_in, 2048, 12288, 12288, p.norm_g, W1T, 0, scr, r, lane); continue; } r -= I1;
        if (r < I2) { transpose_item<0>(p.hg_w_out, 4096, 2048, 2048, nullptr, W2T, 0, scr, r, lane); continue; } r -= I2;
        if (r < I3a) { transpose_item<0>(p.mla_w_in, 2048, 4864, 4864, p.norm_g + 2048, W3T, 0, scr, r, lane); continue; } r -= I3a;
        if (r < I3b) { transpose_item<1>(p.w_kv_down, 2048, 576, 576, p.kv_in_norm_g, W3T, 4864, scr, r, lane); continue; } r -= I3b;
        if (r < I4) { transpose_item<2>(p.mla_w_q_up, 768, 6144, 6144, p.mla_q_norm_g, W4T, 0, scr, r, lane); continue; } r -= I4;
        if (r < I5) { transpose_item<0>(p.w_kv_up, 512, 8192, 8192, p.kv_norm_g, W5T, 0, scr, r, lane); continue; } r -= I5;
        transpose_item<0>(p.mla_w_out, 4096, 2048, 2048, nullptr, W6T, 0, scr, r, lane);
    }
    {
        u32x4* z = (u32x4*)(W3T + (size_t)5440 * 2048);
        for (int i = gw * 64 + lane; i < 192 * 2048 / 8; i += NGW * 64) z[i] = (u32x4){0u, 0u, 0u, 0u};
    }
    bf16_t* XN = (bf16_t*)(p.ws + WS_XN);
    for (int m = gw; m < NTOK; m += NGW) {
        const f32x4* xr = (const f32x4*)(p.x + (size_t)m * 2048) + lane;
        f32x4 v[8]; float s = 0.f;
#pragma unroll
        for (int j = 0; j < 8; ++j) { v[j] = xr[64 * j]; s += (v[j][0] * v[j][0] + v[j][1] * v[j][1]) + (v[j][2] * v[j][2] + v[j][3] * v[j][3]); }
        const float rs = __builtin_amdgcn_rsqf(wave_sum(s) * (1.0f / 2048.0f) + EPS);
        u32x2* o8 = (u32x2*)(XN + (size_t)m * 2048) + lane;
#pragma unroll
        for (int j = 0; j < 8; ++j) { u32x2 w; w.x = cvt_pk_bf16(v[j][0] * rs, v[j][1] * rs); w.y = cvt_pk_bf16(v[j][2] * rs, v[j][3] * rs); o8[64 * j] = w; }
    }
}

__device__ __forceinline__ void hgrn_naive(const Params& p, LAS unsigned char* lds, int tid) {
    if (blockIdx.x >= 64) return;
    const int bh = blockIdx.x, b = bh >> 4, h = bh & 15;
    LAS float* fg = (LAS float*)lds; LAS float* kks = fg + 128; LAS float* qs = kks + 128; LAS float* op = qs + 128; LAS float* red = op + 512;
    const float* F = p.out; const bf16_t* Qh = (const bf16_t*)(p.ws + WS_QH); const bf16_t* VI = (const bf16_t*)(p.ws + WS_VI); bf16_t* GS = (bf16_t*)(p.ws + WS_GS);
    const int v = tid & 255, half = tid >> 8, wave = tid >> 6, lane = tid & 63;
    float S[64];
#pragma unroll
    for (int j = 0; j < 64; ++j) S[j] = 0.f;
    float lb = 0.f;
    if (tid < 128) { const float a = p.hg_lb[h * 128 + tid], bb = p.hg_lb[2048 + h * 128 + tid]; lb = 1.0f / (1.0f + __expf(bb - a)); }
    const float gn = p.hg_g_norm[v];
    for (int t = 0; t < SEQ; ++t) {
        const size_t row = (size_t)b * SEQ + t;
        if (tid < 128) {
            const float f = F[row * 2048 + h * 128 + tid]; const float q = bf2f(Qh[row * 2048 + h * 128 + tid]);
            const float sg = 1.0f / (1.0f + __expf(-f));
            fg[tid] = lb + (1.0f - lb) * sg; kks[tid] = (1.0f - lb) * (1.0f - sg); qs[tid] = q;
        }
        const float iv = bf2f(VI[row * 4096 + h * 256 + v]);
        __syncthreads();
        float o = 0.f;
#pragma unroll
        for (int j = 0; j < 64; ++j) { const int k = half * 64 + j; S[j] = fg[k] * S[j] + kks[k] * iv; o += qs[k] * S[j]; }
        op[half * 256 + v] = o;
        __syncthreads();
        const float of = op[v] + op[256 + v];
        const float sq = wave_sum(of * of);
        if (lane == 0) red[wave] = sq;
        __syncthreads();
        const float tot = (red[0] + red[1]) + (red[2] + red[3]);
        const float rs = __builtin_amdgcn_rsqf(tot * (1.0f / 256.0f) + EPS);
        if (half == 0) { bf16_t* g = GS + row * 4096 + h * 256 + v; const float y = of * rs * gn * bf2f(*g); *g = (bf16_t)(cvt_pk_bf16(y, 0.f) & 0xffffu); }
    }
}

__device__ __forceinline__ float dot2(unsigned a, unsigned b) { return bflo(a) * bflo(b) + bfhi(a) * bfhi(b); }
__device__ __forceinline__ void attn_naive(const Params& p, int gw, int NGW, int lane) {
    const bf16_t* Q = (const bf16_t*)(p.ws + WS_Q); const bf16_t* KN = (const bf16_t*)(p.ws + WS_KN); const bf16_t* KR = (const bf16_t*)(p.ws + WS_KR);
    const bf16_t* V = (const bf16_t*)(p.ws + WS_V); bf16_t* GATE = (bf16_t*)(p.ws + WS_GATE);
    for (int unit = gw; unit < 16384; unit += NGW) {
        const int quar = unit & 3, qblk = (unit >> 2) & 31, bh = unit >> 7, b = bh >> 5, h = bh & 31;
        const int qi = qblk * 64 + lane;
        unsigned qr[96];
        { const u32x4* qp = (const u32x4*)(Q + ((size_t)(bh * 2048 + qi)) * 192);
#pragma unroll
          for (int i = 0; i < 24; ++i) { const u32x4 t = qp[i]; qr[4 * i] = t.x; qr[4 * i + 1] = t.y; qr[4 * i + 2] = t.z; qr[4 * i + 3] = t.w; } }
        float o[32];
#pragma unroll
        for (int d = 0; d < 32; ++d) o[d] = 0.f;
        float mx = -1e30f, l = 0.f;
        const int jmax = qblk * 64 + 63;
        for (int j = 0; j <= jmax; ++j) {
            const u32x4* kp = (const u32x4*)(KN + ((size_t)(bh * 2048 + j)) * 128);
            const u32x4* rp = (const u32x4*)(KR + ((size_t)(b * 2048 + j)) * 64);
            float s = 0.f;
#pragma unroll
            for (int i = 0; i < 96; ++i) asm volatile("" : "+v"(qr[i]));
#pragma unroll
            for (int i = 0; i < 16; ++i) { const u32x4 kv = kp[i]; s += dot2(qr[4 * i], kv.x) + dot2(qr[4 * i + 1], kv.y) + dot2(qr[4 * i + 2], kv.z) + dot2(qr[4 * i + 3], kv.w); if ((i & 3) == 3) asm volatile("" ::: "memory"); }
#pragma unroll
            for (int i = 0; i < 8; ++i) { const u32x4 kv = rp[i]; s += dot2(qr[64 + 4 * i], kv.x) + dot2(qr[64 + 4 * i + 1], kv.y) + dot2(qr[64 + 4 * i + 2], kv.z) + dot2(qr[64 + 4 * i + 3], kv.w); if ((i & 3) == 3) asm volatile("" ::: "memory"); }
            if (j <= qi) {
                if (s > mx) { const float al = __builtin_amdgcn_exp2f(mx - s); l *= al;
#pragma unroll
                    for (int d = 0; d < 32; ++d) o[d] *= al;
                    mx = s; }
                const float pe = __builtin_amdgcn_exp2f(s - mx); l += pe;
                const u32x4* vp = (const u32x4*)(V + ((size_t)(bh * 2048 + j)) * 128 + quar * 32);
#pragma unroll
                for (int i = 0; i < 4; ++i) { const u32x4 vv = vp[i];
                    o[8 * i] += pe * bflo(vv.x); o[8 * i + 1] += pe * bfhi(vv.x); o[8 * i + 2] += pe * bflo(vv.y); o[8 * i + 3] += pe * bfhi(vv.y);
                    o[8 * i + 4] += pe * bflo(vv.z); o[8 * i + 5] += pe * bfhi(vv.z); o[8 * i + 6] += pe * bflo(vv.w); o[8 * i + 7] += pe * bfhi(vv.w); }
            }
        }
        const float il = 1.0f / l;
        u32x4* gp = (u32x4*)(GATE + ((size_t)(b * 2048 + qi)) * 4096 + h * 128 + quar * 32);
#pragma unroll
        for (int i = 0; i < 4; ++i) { const u32x4 g = gp[i]; u32x4 w;
            w.x = cvt_pk_bf16(o[8 * i] * il * bflo(g.x), o[8 * i + 1] * il * bfhi(g.x)); w.y = cvt_pk_bf16(o[8 * i + 2] * il * bflo(g.y), o[8 * i + 3] * il * bfhi(g.y));
            w.z = cvt_pk_bf16(o[8 * i + 4] * il * bflo(g.z), o[8 * i + 5] * il * bfhi(g.z)); w.w = cvt_pk_bf16(o[8 * i + 6] * il * bflo(g.w), o[8 * i + 7] * il * bfhi(g.w));
            gp[i] = w; }
    }
}

__device__ __forceinline__ void final_norm(const Params& p, int gw, int NGW, int lane) {
    const float* ss2 = (const float*)(p.ws + WS_SS2);
    for (int m = gw; m < NTOK; m += NGW) {
        const float t = wave_sum(lane < 32 ? ss2[(size_t)m * 32 + lane] : 0.f);
        const float rs = __builtin_amdgcn_rsqf(t * (1.0f / 2048.0f) + EPS);
        f32x4* xr = (f32x4*)(p.out + (size_t)m * 2048) + lane; const f32x4* gr = (const f32x4*)p.final_norm_g + lane;
#pragma unroll
        for (int j = 0; j < 8; ++j) { const f32x4 v = xr[64 * j], g = gr[64 * j]; xr[64 * j] = v * rs * g; }
    }
}

__global__ void __launch_bounds__(512) yoco_fwd(Params p) {
    extern __shared__ __attribute__((aligned(16))) unsigned char lds_raw[];
    LAS unsigned char* lds = (LAS unsigned char*)lds_raw;
    cg::grid_group grid = cg::this_grid();
    const int tid = threadIdx.x, lane = tid & 63, wave = __builtin_amdgcn_readfirstlane(tid >> 6);
    const int G = gridDim.x, gw = blockIdx.x * 8 + wave, NGW = G * 8;
    unsigned char* ws = p.ws;
    phase0(p, lds, wave, lane, gw, NGW);
    grid.sync();
    { pg8::Gemm g{(const bf16_t*)(ws + WS_XN), (const bf16_t*)(ws + WS_W1T), NTOK, 12288, 2048}; pg8::StaticOrder S; S.init(NTOK, 12288, G, (int)blockIdx.x);
      EpiG1 E{(bf16_t*)(ws + WS_QH), p.out, (bf16_t*)(ws + WS_VI), (bf16_t*)(ws + WS_GS)};
      pg8::gemm_phase<EpiG1, pg8::StaticOrder, PG8_ALIGN, PG8_SP2>(lds, g, S, E); }
    grid.sync();
    hgrn_naive(p, lds, tid);
    grid.sync();
    { pg8::Gemm g{(const bf16_t*)(ws + WS_GS), (const bf16_t*)(ws + WS_W2T), NTOK, 2048, 4096}; pg8::StaticOrder S; S.init(NTOK, 2048, G, (int)blockIdx.x);
      EpiRes<true> E{p.x, p.out, (bf16_t*)(ws + WS_H1B), (float*)(ws + WS_SS1)};
      pg8::gemm_phase<EpiRes<true>, pg8::StaticOrder, PG8_ALIGN, PG8_SP2>(lds, g, S, E); }
    grid.sync();
    { pg8::Gemm g{(const bf16_t*)(ws + WS_H1B), (const bf16_t*)(ws + WS_W3T), NTOK, 5632, 2048}; pg8::StaticOrder S; S.init(NTOK, 5632, G, (int)blockIdx.x);
      EpiG3 E{(const float*)(ws + WS_SS1), (bf16_t*)(ws + WS_CQ), (bf16_t*)(ws + WS_GATE), (bf16_t*)(ws + WS_C), (bf16_t*)(ws + WS_KR), (float*)(ws + WS_SSQ), (float*)(ws + WS_SSC)};
      pg8::gemm_phase<EpiG3, pg8::StaticOrder, PG8_ALIGN, PG8_SP2>(lds, g, S, E); }
    grid.sync();
    { pg8::Gemm g{(const bf16_t*)(ws + WS_CQ), (const bf16_t*)(ws + WS_W4T), NTOK, 6144, 768}; pg8::StaticOrder S; S.init(NTOK, 6144, G, (int)blockIdx.x);
      EpiQ E{(const float*)(ws + WS_SSQ), (bf16_t*)(ws + WS_Q)};
      pg8::gemm_phase<EpiQ, pg8::StaticOrder, PG8_ALIGN, PG8_SP2>(lds, g, S, E); }
    { pg8::Gemm g{(const bf16_t*)(ws + WS_C), (const bf16_t*)(ws + WS_W5T), NTOK, 8192, 512}; pg8::StaticOrder S; S.init(NTOK, 8192, G, (int)blockIdx.x);
      EpiKV E{(const float*)(ws + WS_SSC), (bf16_t*)(ws + WS_KN), (bf16_t*)(ws + WS_V)};
      pg8::gemm_phase<EpiKV, pg8::StaticOrder, PG8_ALIGN, PG8_SP2>(lds, g, S, E); }
    grid.sync();
    attn_naive(p, gw, NGW, lane);
    grid.sync();
    { pg8::Gemm g{(const bf16_t*)(ws + WS_GATE), (const bf16_t*)(ws + WS_W6T), NTOK, 2048, 4096}; pg8::StaticOrder S; S.init(NTOK, 2048, G, (int)blockIdx.x);
      EpiRes<false> E{p.out, p.out, nullptr, (float*)(ws + WS_SS2)};
      pg8::gemm_phase<EpiRes<false>, pg8::StaticOrder, PG8_ALIGN, PG8_SP2>(lds, g, S, E); }
    grid.sync();
    final_norm(p, gw, NGW, lane);
}

extern "C" void kernel_launch(void* const* d_in, const int* in_sizes, int n_in, void* d_out, int out_size, void* d_ws, size_t ws_size, hipStream_t stream) {
    static int grid = 0;
    if (grid == 0) {
        if (n_in != 15 || out_size != NTOK * DM || ws_size < WS_NEED) { fprintf(stderr, "kernel_launch: unexpected shapes (n_in %d out %d ws %zu)\n", n_in, out_size, ws_size); grid = -1; return; }
        int dev = 0, cus = 0, per_cu = 0;
        hipGetDevice(&dev); hipDeviceGetAttribute(&cus, hipDeviceAttributeMultiprocessorCount, dev);
        hipFuncSetAttribute((const void*)yoco_fwd, hipFuncAttributeMaxDynamicSharedMemorySize, LDS_BYTES);
        hipOccupancyMaxActiveBlocksPerMultiprocessor(&per_cu, (const void*)yoco_fwd, 512, LDS_BYTES);
        if (per_cu < 1) per_cu = 1;
        (void)hipGetLastError();
        grid = cus * per_cu;
    }
    if (grid < 0) return;
    Params p{};
    p.x = (const float*)d_in[0]; p.norm_g = (const float*)d_in[1]; p.hg_w_in = (const float*)d_in[2]; p.hg_g_norm = (const float*)d_in[3]; p.hg_w_out = (const float*)d_in[4];
    p.hg_lb = (const float*)d_in[5]; p.kv_in_norm_g = (const float*)d_in[6]; p.w_kv_down = (const float*)d_in[7]; p.kv_norm_g = (const float*)d_in[8]; p.w_kv_up = (const float*)d_in[9];
    p.mla_w_in = (const float*)d_in[10]; p.mla_q_norm_g = (const float*)d_in[11]; p.mla_w_q_up = (const float*)d_in[12]; p.mla_w_out = (const float*)d_in[13]; p.final_norm_g = (const float*)d_in[14];
    p.out = (float*)d_out; p.ws = (unsigned char*)d_ws;
    void* args[] = {&p};
    hipError_t e = hipLaunchCooperativeKernel((const void*)yoco_fwd, dim3(grid), dim3(512), args, LDS_BYTES, stream);
    if (e != hipSuccess) fprintf(stderr, "cooperative launch failed: %s (grid %d)\n", hipGetErrorString(e), grid);
}
```

```cpp
#include <hip/hip_runtime.h>
#include <hip/hip_cooperative_groups.h>
#include <cstdio>
#include <cstdint>
namespace cg = cooperative_groups;
namespace pg8 {
#define PG8_LAS __attribute__((address_space(3)))
typedef unsigned short bf16_t;
typedef short bf16x8 __attribute__((ext_vector_type(8)));
typedef float f32x4 __attribute__((ext_vector_type(4)));
typedef unsigned u32x4 __attribute__((ext_vector_type(4)));
constexpr int BM = 256, BK = 64, HALF = 128, HTB = HALF * BK * 2  , STAGE_BYTES = 8 * HTB, NXCD = 8, WGM = 8;

__host__ __device__ __forceinline__ int lds_byte(int r, int c) { const int st = (r >> 4) * 2 + (c >> 5), rr = r & 15, cc = c & 31, ob = rr * 64 + cc * 2; return st * 1024 + (ob ^ (((ob >> 9) & 1) << 5)); }
__host__ __device__ __forceinline__ void stage_rc(int b, int& R, int& C) { const int st = b / 1024, sb = b % 1024, swz = sb ^ (((sb >> 9) & 1) << 5); R = (st >> 1) * 16 + swz / 64; C = (st & 1) * 32 + (swz % 64) / 2; }
__host__ __device__ __forceinline__ int perm32(int rho) { const int n = rho >> 4, i = rho & 15; return 8 * (i >> 2) + 4 * n + (i & 3); }

struct Unit { int pm, pn; };
struct Gemm { const bf16_t* A; const bf16_t* Bt; int M, N, K; };

struct StaticOrder {
    int nM, nN, nwg, G, c;
    __host__ __device__ void init(int M, int N, int G_, int c_) { nM = M / BM; nN = N / BM; nwg = nM * nN; G = G_; c = c_; }
    __host__ __device__ bool next(int i, Unit& u) const {
        const long L = (long)i * G + c; if (L >= nwg) return false;
        int wgid = (int)L; { const int q = nwg / NXCD, r = nwg % NXCD, xcd = wgid % NXCD, off = wgid / NXCD; wgid = (xcd < r ? xcd * (q + 1) : r * (q + 1) + (xcd - r) * q) + off; }
        const int nig = WGM * nN, gid = wgid / nig, fm = gid * WGM, gsz = (nM - fm) < WGM ? (nM - fm) : WGM;
        u.pm = fm + ((wgid % nig) % gsz); u.pn = (wgid % nig) / gsz; return true;
    }
    __device__ __forceinline__ void a_ready(const Unit&) const {}
    __device__ __forceinline__ void done(const Unit&) const {}
};

__device__ __forceinline__ unsigned cvt_pk_bf16(float lo, float hi) { unsigned r; asm volatile("v_cvt_pk_bf16_f32 %0, %1, %2" : "=v"(r) : "v"(lo), "v"(hi)); return r; }
__device__ __forceinline__ int pg8_lane_id() { int l; asm volatile("v_mbcnt_lo_u32_b32 %0, -1, 0\n\tv_mbcnt_hi_u32_b32 %0, -1, %0" : "=v"(l)); return l; }
template <class Epi, class Sched, bool ALIGN_EPI = false, bool SP2 = false>
__device__ __forceinline__ void gemm_phase(PG8_LAS unsigned char* lds, const Gemm g, const Sched& S, const Epi& E, int wave_id) {
    const int wid = wave_id, lane = pg8_lane_id(), tid = wid * 64 + lane, wr = wid >> 2, wc = wid & 3, fr = lane & 15, fq = lane >> 4;
    const int K = g.K, nt = K / BK;
    unsigned voffA[2], voffB[2];
#pragma unroll
    for (int i = 0; i < 2; ++i) { int R, C; stage_rc(tid * 16 + i * 8192, R, C); const int Rb = Epi::PERM ? ((R & ~31) + perm32(R & 31)) : R;
        voffA[i] = (unsigned)(R * K + C) * 2u; voffB[i] = (unsigned)(Rb * K + C) * 2u; }
    const size_t kstep = (size_t)(BK * 2);
    const size_t hstep = (size_t)HALF * K * 2;
    const size_t tstep = 2 * hstep;
    const unsigned ldsw = (unsigned)wid * 1024u;
    const int aoff = lds_byte(wr * 64 + fr, fq * 8), boff = lds_byte(wc * 32 + fr, fq * 8);
#define PG8_SA(b, h) (((b) * 2 + (h)) * HTB)
#define PG8_SB(b, h) ((4 + (b) * 2 + (h)) * HTB)
#define PG8_STAGE(bufoff, gbase, voff) do { _Pragma("unroll") for (int _i = 0; _i < 2; ++_i) \
        __builtin_amdgcn_global_load_lds((const unsigned*)((const char*)(gbase) + (voff)[_i]), (PG8_LAS unsigned*)(lds + (bufoff) + ldsw + _i * 8192), 16, 0, 0); } while (0)
#define PG8_LDA(dst, b, h) do { _Pragma("unroll") for (int m = 0; m < 4; ++m) _Pragma("unroll") for (int k = 0; k < 2; ++k) dst[m][k] = *(const PG8_LAS bf16x8*)(lds + PG8_SA(b, h) + aoff + m * 2048 + k * 1024); } while (0)
#define PG8_LDB(dst, b, h) do { _Pragma("unroll") for (int n = 0; n < 2; ++n) _Pragma("unroll") for (int k = 0; k < 2; ++k) dst[n][k] = *(const PG8_LAS bf16x8*)(lds + PG8_SB(b, h) + boff + n * 2048 + k * 1024); } while (0)
#define PG8_MMA(ai, bj, At, Bt) do { __builtin_amdgcn_s_setprio(1); _Pragma("unroll") for (int m = 0; m < 4; ++m) _Pragma("unroll") for (int n = 0; n < 2; ++n) _Pragma("unroll") for (int k = 0; k < 2; ++k) \
        acc[ai][bj][m][n] = __builtin_amdgcn_mfma_f32_16x16x32_bf16(Bt[n][k], At[m][k], acc[ai][bj][m][n], 0, 0, 0); __builtin_amdgcn_s_setprio(0); } while (0)
#define PG8_WAIT_V(n) asm volatile("s_waitcnt vmcnt(" #n ")" ::: "memory")
#define PG8_WAIT_L(n) asm volatile("s_waitcnt lgkmcnt(" #n ")" ::: "memory")
#define PG8_BAR __builtin_amdgcn_s_barrier()
#define PG8_SCHED __builtin_amdgcn_sched_barrier(0)
    Unit cur, nxt; int ui = 0;
    if (!S.next(0, cur)) return;
    f32x4 acc[2][2][4][2];
#pragma unroll
    for (int a = 0; a < 2; ++a)
#pragma unroll
        for (int b = 0; b < 2; ++b)
#pragma unroll
            for (int m = 0; m < 4; ++m)
#pragma unroll
                for (int n = 0; n < 2; ++n) acc[a][b][m][n] = (f32x4){0.f, 0.f, 0.f, 0.f};
    bf16x8 At[4][2], B0[2][2], B1[2][2];
    const char* cA = (const char*)g.A + (size_t)cur.pm * tstep; const char* cB = (const char*)g.Bt + (size_t)cur.pn * tstep;
    S.a_ready(cur);
    if constexpr (SP2) {
        PG8_STAGE(PG8_SB(0, 0), cB, voffB); PG8_STAGE(PG8_SB(0, 1), cB + hstep, voffB); PG8_STAGE(PG8_SA(0, 0), cA, voffA); PG8_STAGE(PG8_SA(0, 1), cA + hstep, voffA);
        if (wr == 1) PG8_BAR;
        PG8_WAIT_V(2); PG8_BAR;
        PG8_STAGE(PG8_SB(1, 0), cB + kstep, voffB); PG8_STAGE(PG8_SA(1, 0), cA + kstep, voffA); PG8_STAGE(PG8_SB(1, 1), cB + hstep + kstep, voffB);
        PG8_WAIT_V(6); PG8_BAR;
    } else {
        PG8_STAGE(PG8_SB(0, 0), cB, voffB); PG8_STAGE(PG8_SA(0, 0), cA, voffA); PG8_STAGE(PG8_SB(0, 1), cB + hstep, voffB); PG8_STAGE(PG8_SA(0, 1), cA + hstep, voffA);
        if (wr == 1) PG8_BAR;
        PG8_WAIT_V(4); PG8_BAR;
        PG8_STAGE(PG8_SB(1, 0), cB + kstep, voffB); PG8_STAGE(PG8_SA(1, 0), cA + kstep, voffA); PG8_STAGE(PG8_SB(1, 1), cB + hstep + kstep, voffB);
        PG8_WAIT_V(6); PG8_BAR;
    }
    for (;;) {
        const bool has_next = S.next(ui + 1, nxt);
        const char* nA = has_next ? (const char*)g.A + (size_t)nxt.pm * tstep : cA; const char* nB = has_next ? (const char*)g.Bt + (size_t)nxt.pn * tstep : cB;
        for (int t = 0; t < nt; t += 2) {
            const bool last = (t == nt - 2);
            const char* a1 = cA + (size_t)(t + 1) * kstep;
            const char* a2 = last ? nA : cA + (size_t)(t + 2) * kstep; const char* b2 = last ? nB : cB + (size_t)(t + 2) * kstep;
            const char* a3 = a2 + kstep; const char* b3 = b2 + kstep;
            if (last && has_next) S.a_ready(nxt);
            if constexpr (SP2) {
            PG8_LDB(B0, 0, 0); PG8_LDB(B1, 0, 1); PG8_SCHED; PG8_LDA(At, 0, 0); PG8_STAGE(PG8_SA(1, 1), a1 + hstep, voffA);
            PG8_WAIT_V(8); PG8_WAIT_L(0); PG8_BAR; PG8_MMA(0, 0, At, B0); PG8_MMA(0, 1, At, B1); PG8_BAR; PG8_SCHED;
            PG8_LDA(At, 0, 1); PG8_STAGE(PG8_SB(0, 0), b2, voffB); PG8_STAGE(PG8_SB(0, 1), b2 + hstep, voffB); PG8_STAGE(PG8_SA(0, 0), a2, voffA);
            PG8_WAIT_V(8); PG8_WAIT_L(0); PG8_BAR; PG8_MMA(1, 0, At, B0); PG8_MMA(1, 1, At, B1); PG8_BAR; PG8_SCHED;
            PG8_LDB(B0, 1, 0); PG8_LDB(B1, 1, 1); PG8_SCHED; PG8_LDA(At, 1, 0); PG8_STAGE(PG8_SA(0, 1), a2 + hstep, voffA);
            PG8_WAIT_V(8); PG8_WAIT_L(0); PG8_BAR; PG8_MMA(0, 0, At, B0); PG8_MMA(0, 1, At, B1); PG8_BAR; PG8_SCHED;
            PG8_LDA(At, 1, 1); PG8_STAGE(PG8_SB(1, 0), b3, voffB); PG8_STAGE(PG8_SB(1, 1), b3 + hstep, voffB); PG8_STAGE(PG8_SA(1, 0), a3, voffA);
            PG8_WAIT_V(8); PG8_WAIT_L(0); PG8_BAR; PG8_MMA(1, 0, At, B0); PG8_MMA(1, 1, At, B1); PG8_BAR; PG8_SCHED;
            } else {
            PG8_LDB(B0, 0, 0); PG8_SCHED; PG8_LDA(At, 0, 0); PG8_STAGE(PG8_SA(1, 1), a1 + hstep, voffA);
            PG8_WAIT_L(8); PG8_BAR; PG8_WAIT_L(0); PG8_MMA(0, 0, At, B0); PG8_BAR; PG8_SCHED;
            PG8_LDB(B1, 0, 1); PG8_STAGE(PG8_SB(0, 0), b2, voffB);
            PG8_BAR; PG8_WAIT_L(0); PG8_MMA(0, 1, At, B1); PG8_BAR;
            PG8_LDA(At, 0, 1); PG8_STAGE(PG8_SA(0, 0), a2, voffA);
            PG8_BAR; PG8_WAIT_L(0); PG8_MMA(1, 0, At, B0); PG8_BAR; PG8_SCHED;
            PG8_STAGE(PG8_SB(0, 1), b2 + hstep, voffB);
            PG8_WAIT_V(6); PG8_BAR; PG8_MMA(1, 1, At, B1); PG8_BAR;
            PG8_LDB(B0, 1, 0); PG8_SCHED; PG8_LDA(At, 1, 0); PG8_STAGE(PG8_SA(0, 1), a2 + hstep, voffA);
            PG8_WAIT_L(8); PG8_BAR; PG8_WAIT_L(0); PG8_MMA(0, 0, At, B0); PG8_BAR; PG8_SCHED;
            PG8_LDB(B1, 1, 1); PG8_STAGE(PG8_SB(1, 0), b3, voffB);
            PG8_BAR; PG8_WAIT_L(0); PG8_MMA(0, 1, At, B1); PG8_BAR;
            PG8_LDA(At, 1, 1); PG8_STAGE(PG8_SA(1, 0), a3, voffA);
            PG8_BAR; PG8_WAIT_L(0); PG8_MMA(1, 0, At, B0); PG8_BAR; PG8_SCHED;
            PG8_STAGE(PG8_SB(1, 1), b3 + hstep, voffB);
            PG8_WAIT_V(6); PG8_BAR; PG8_MMA(1, 1, At, B1); PG8_BAR;
            }
        }
        if constexpr (ALIGN_EPI) { if (wr == 0) PG8_BAR; }
        if constexpr (!Epi::AFTER_DRAIN) { E(acc, cur, wr, wc, fr, fq); S.done(cur); }
        if (!has_next) break;
#pragma unroll
        for (int a = 0; a < 2; ++a)
#pragma unroll
            for (int b = 0; b < 2; ++b)
#pragma unroll
                for (int m = 0; m < 4; ++m)
#pragma unroll
                    for (int n = 0; n < 2; ++n) acc[a][b][m][n] = (f32x4){0.f, 0.f, 0.f, 0.f};
        cur = nxt; cA = nA; cB = nB; ++ui;
        if constexpr (ALIGN_EPI) { if (wr == 1) PG8_BAR; }
    }
    PG8_WAIT_V(0);
    if constexpr (!ALIGN_EPI) { if (wr == 0) PG8_BAR; }
    PG8_BAR;
    if constexpr (Epi::AFTER_DRAIN) { E.fused(acc, cur, wr, wc, fr, fq, lds, wid, lane); S.done(cur); }
#undef PG8_SA
#undef PG8_SB
#undef PG8_STAGE
#undef PG8_LDA
#undef PG8_LDB
#undef PG8_MMA
#undef PG8_WAIT_V
#undef PG8_WAIT_L
#undef PG8_BAR
#undef PG8_SCHED
}
}
#define PG8_ALIGN true
#define PG8_SP2 true
#define LAS __attribute__((address_space(3)))
typedef unsigned short bf16_t;
typedef float f32x4 __attribute__((ext_vector_type(4)));
typedef unsigned u32x4 __attribute__((ext_vector_type(4)));
typedef unsigned u32x2 __attribute__((ext_vector_type(2)));
using pg8::cvt_pk_bf16;
constexpr int NTOK = 8192, DM = 2048, SEQ = 2048, DI = 4096;
constexpr float EPS = 1e-6f;
constexpr size_t MiB = 1u << 20;
constexpr size_t WS_W2T = 1 * MiB, WS_W3T = 17 * MiB, WS_W4T = 39 * MiB, WS_W5T = 48 * MiB, WS_W6T = 56 * MiB;
constexpr size_t WS_QH = 72 * MiB, WS_VI = 104 * MiB, WS_GS = 168 * MiB, WS_ST = 232 * MiB, WS_W1T = 232 * MiB, WS_XN = 280 * MiB;
constexpr size_t WS_H1B = 72 * MiB, WS_Q = 72 * MiB, WS_KN = 168 * MiB, WS_GATE = 232 * MiB, WS_CQ = 296 * MiB, WS_C = 308 * MiB, WS_KR = 316 * MiB, WS_V = 317 * MiB;
constexpr size_t WS_SS1 = 381 * MiB, WS_SSQ = 382 * MiB, WS_SSC = 382 * MiB + 512 * 1024, WS_SS2 = 383 * MiB, WS_NEED = 384 * MiB;
constexpr int LDS_BYTES = 147456;
constexpr float QSCALE = 0.07216878364870322f * 1.4426950408889634f;

struct Params {
    const float* x; const float* norm_g; const float* hg_w_in; const float* hg_g_norm; const float* hg_w_out; const float* hg_lb;
    const float* kv_in_norm_g; const float* w_kv_down; const float* kv_norm_g; const float* w_kv_up; const float* mla_w_in; const float* mla_q_norm_g;
    const float* mla_w_q_up; const float* mla_w_out; const float* final_norm_g;
    float* out; unsigned char* ws;
};

__device__ __forceinline__ float bf2f(bf16_t v) { return __uint_as_float((unsigned)v << 16); }
__device__ __forceinline__ float bflo(unsigned u) { return __uint_as_float(u << 16); }
__device__ __forceinline__ float bfhi(unsigned u) { return __uint_as_float(u & 0xffff0000u); }
__device__ __forceinline__ float silu_f(float v) { return v * __builtin_amdgcn_rcpf(1.0f + __builtin_amdgcn_exp2f(-1.4426950408889634f * v)); }
__device__ __forceinline__ float wave_sum(float v) {
#pragma unroll
    for (int o = 1; o < 64; o <<= 1) v += __shfl_xor(v, o);
    return v;
}
__device__ __forceinline__ void store8_bf16(bf16_t* p, const f32x4& a, const f32x4& b) {
    u32x4 w; w.x = cvt_pk_bf16(a[0], a[1]); w.y = cvt_pk_bf16(a[2], a[3]); w.z = cvt_pk_bf16(b[0], b[1]); w.w = cvt_pk_bf16(b[2], b[3]);
    *(u32x4*)p = w;
}
__device__ __forceinline__ void rope8(f32x4& a, f32x4& b, int pos, int j0) {
    float v[8] = {a[0], a[1], a[2], a[3], b[0], b[1], b[2], b[3]};
#pragma unroll
    for (int p = 0; p < 4; ++p) {
        const float inv = __builtin_amdgcn_exp2f(-(float)(j0 + p) * 0.41524101186092029f);
        float rev = (float)pos * inv * 0.15915494309189535f; rev = rev - floorf(rev);
        const float c = __builtin_amdgcn_cosf(rev), s = __builtin_amdgcn_sinf(rev);
        const float x1 = v[2 * p], x2 = v[2 * p + 1];
        v[2 * p] = x1 * c - x2 * s; v[2 * p + 1] = x2 * c + x1 * s;
    }
    a = (f32x4){v[0], v[1], v[2], v[3]}; b = (f32x4){v[4], v[5], v[6], v[7]};
}

typedef const f32x4 (&AccRef)[2][2][4][2];
struct EpiG1 {
    static constexpr bool PERM = true, AFTER_DRAIN = false;
    bf16_t* Qh; float* F; bf16_t* VI; bf16_t* GS;
    __device__ __forceinline__ void operator()(AccRef acc, const pg8::Unit& u, int wr, int wc, int fr, int fq) const {
        const int pn = u.pn;
#pragma unroll
        for (int ai = 0; ai < 2; ++ai)
#pragma unroll
            for (int m = 0; m < 4; ++m) {
                const size_t row = (size_t)(u.pm * 256 + ai * 128 + wr * 64 + m * 16 + fr);
#pragma unroll
                for (int bj = 0; bj < 2; ++bj) {
                    const int col = pn * 256 + bj * 128 + wc * 32 + 8 * fq;
                    f32x4 a = acc[ai][bj][m][0], b = acc[ai][bj][m][1];
                    if (pn < 8) store8_bf16(Qh + row * 2048 + col, a, b);
                    else if (pn < 16) { float* o = F + row * 2048 + (col - 2048); *(f32x4*)o = a; *(f32x4*)(o + 4) = b; }
                    else if (pn < 32) store8_bf16(VI + row * 4096 + (col - 4096), a, b);
                    else {
#pragma unroll
                        for (int j = 0; j < 4; ++j) { a[j] = silu_f(a[j]); b[j] = silu_f(b[j]); }
                        store8_bf16(GS + row * 4096 + (col - 8192), a, b);
                    }
                }
            }
    }
};
template <bool WB> struct EpiRes {
    static constexpr bool PERM = true, AFTER_DRAIN = false;
    const float* base; float* out; bf16_t* outb; float* ss;
    __device__ __forceinline__ void operator()(AccRef acc, const pg8::Unit& u, int wr, int wc, int fr, int fq) const {
#pragma unroll
        for (int ai = 0; ai < 2; ++ai)
#pragma unroll
            for (int m = 0; m < 4; ++m) {
                const size_t row = (size_t)(u.pm * 256 + ai * 128 + wr * 64 + m * 16 + fr);
                float s = 0.f;
#pragma unroll
                for (int bj = 0; bj < 2; ++bj) {
                    const int col = u.pn * 256 + bj * 128 + wc * 32 + 8 * fq;
                    const size_t off = row * 2048 + col;
                    f32x4 a = acc[ai][bj][m][0] + *(const f32x4*)(base + off), b = acc[ai][bj][m][1] + *(const f32x4*)(base + off + 4);
                    *(f32x4*)(out + off) = a; *(f32x4*)(out + off + 4) = b;
                    if (WB) store8_bf16(outb + off, a, b);
                    s += (a[0] * a[0] + a[1] * a[1]) + (a[2] * a[2] + a[3] * a[3]) + (b[0] * b[0] + b[1] * b[1]) + (b[2] * b[2] + b[3] * b[3]);
                }
                s += __shfl_xor(s, 16); s += __shfl_xor(s, 32);
                if (fq == 0) ss[row * 32 + u.pn * 4 + wc] = s;
            }
    }
};
struct EpiG3 {
    static constexpr bool PERM = true, AFTER_DRAIN = false;
    const float* ss1; bf16_t* CQ; bf16_t* GATE; bf16_t* C; bf16_t* KR; float* ssq; float* ssc;
    __device__ __forceinline__ void operator()(AccRef acc, const pg8::Unit& u, int wr, int wc, int fr, int fq) const {
        const int pn = u.pn;
#pragma unroll
        for (int ai = 0; ai < 2; ++ai)
#pragma unroll
            for (int m = 0; m < 4; ++m) {
                const size_t row = (size_t)(u.pm * 256 + ai * 128 + wr * 64 + m * 16 + fr);
                float t = 0.f;
                { const f32x4* sp = (const f32x4*)(ss1 + row * 32);
#pragma unroll
                  for (int i = 0; i < 8; ++i) { const f32x4 q = sp[i]; t += (q[0] + q[1]) + (q[2] + q[3]); } }
                const float rs = __builtin_amdgcn_rsqf(t * (1.0f / 2048.0f) + EPS);
                float s = 0.f;
#pragma unroll
                for (int bj = 0; bj < 2; ++bj) {
                    const int lc = bj * 128 + wc * 32 + 8 * fq;
                    f32x4 a = acc[ai][bj][m][0] * rs, b = acc[ai][bj][m][1] * rs;
                    if (pn < 3) { store8_bf16(CQ + row * 768 + pn * 256 + lc, a, b); }
                    else if (pn < 19) {
#pragma unroll
                        for (int j = 0; j < 4; ++j) { a[j] = silu_f(a[j]); b[j] = silu_f(b[j]); }
                        store8_bf16(GATE + row * 4096 + (pn - 3) * 256 + lc, a, b);
                    } else if (pn < 21) { store8_bf16(C + row * 512 + (pn - 19) * 256 + lc, a, b); }
                    else if (bj == 0 && wc < 2) { rope8(a, b, (int)(row & 2047), wc * 16 + 4 * fq); store8_bf16(KR + row * 64 + lc, a, b); }
                    s += (a[0] * a[0] + a[1] * a[1]) + (a[2] * a[2] + a[3] * a[3]) + (b[0] * b[0] + b[1] * b[1]) + (b[2] * b[2] + b[3] * b[3]);
                }
                s += __shfl_xor(s, 16); s += __shfl_xor(s, 32);
                if (fq == 0) { if (pn < 3) ssq[row * 16 + pn * 4 + wc] = s; else if (pn == 19 || pn == 20) ssc[row * 8 + (pn - 19) * 4 + wc] = s; }
            }
    }
};
struct EpiQ {
    static constexpr bool PERM = true, AFTER_DRAIN = false;
    const float* ssq; bf16_t* Q;
    __device__ __forceinline__ void operator()(AccRef acc, const pg8::Unit& u, int wr, int wc, int fr, int fq) const {
        const int pn = u.pn;
#pragma unroll
        for (int ai = 0; ai < 2; ++ai)
#pragma unroll
            for (int m = 0; m < 4; ++m) {
                const int row = u.pm * 256 + ai * 128 + wr * 64 + m * 16 + fr;
                const f32x4* sp = (const f32x4*)(ssq + (size_t)row * 16);
                const f32x4 q0 = sp[0], q1 = sp[1], q2 = sp[2];
                const float t = ((q0[0] + q0[1]) + (q0[2] + q0[3])) + ((q1[0] + q1[1]) + (q1[2] + q1[3])) + ((q2[0] + q2[1]) + (q2[2] + q2[3]));
                const float rs = __builtin_amdgcn_rsqf(t * (1.0f / 768.0f) + EPS) * QSCALE;
                const int b_ = row >> 11, s_ = row & 2047;
#pragma unroll
                for (int bj = 0; bj < 2; ++bj) {
                    f32x4 a = acc[ai][bj][m][0] * rs, b = acc[ai][bj][m][1] * rs;
                    if (pn < 16) { const int h = pn * 2 + bj; store8_bf16(Q + ((size_t)((b_ * 32 + h) * 2048 + s_)) * 192 + wc * 32 + 8 * fq, a, b); }
                    else { const int h = (pn - 16) * 4 + bj * 2 + (wc >> 1), off = (wc & 1) * 32 + 8 * fq;
                        rope8(a, b, s_, off >> 1); store8_bf16(Q + ((size_t)((b_ * 32 + h) * 2048 + s_)) * 192 + 128 + off, a, b); }
                }
            }
    }
};
struct EpiKV {
    static constexpr bool PERM = true, AFTER_DRAIN = false;
    const float* ssc; bf16_t* KN; bf16_t* V;
    __device__ __forceinline__ void operator()(AccRef acc, const pg8::Unit& u, int wr, int wc, int fr, int fq) const {
        const int h = u.pn;
#pragma unroll
        for (int ai = 0; ai < 2; ++ai)
#pragma unroll
            for (int m = 0; m < 4; ++m) {
                const int row = u.pm * 256 + ai * 128 + wr * 64 + m * 16 + fr;
                const f32x4* sp = (const f32x4*)(ssc + (size_t)row * 8);
                const f32x4 q0 = sp[0], q1 = sp[1];
                const float t = ((q0[0] + q0[1]) + (q0[2] + q0[3])) + ((q1[0] + q1[1]) + (q1[2] + q1[3]));
                const float rs = __builtin_amdgcn_rsqf(t * (1.0f / 512.0f) + EPS);
                const int b_ = row >> 11, s_ = row & 2047;
                const size_t o = ((size_t)((b_ * 32 + h) * 2048 + s_)) * 128 + wc * 32 + 8 * fq;
                store8_bf16(KN + o, acc[ai][0][m][0] * rs, acc[ai][0][m][1] * rs);
                store8_bf16(V + o, acc[ai][1][m][0] * rs, acc[ai][1][m][1] * rs);
            }
    }
};

template <int MODE> __device__ __forceinline__ int src_col(int n) {
    if (MODE == 0) return n;
    if (MODE == 1) { if (n < 512) return n; const int o = n - 512; return 512 + (o >> 1) + 32 * (o & 1); }
    if (n < 4096) return (n >> 7) * 192 + (n & 127);
    const int r = n - 4096, h = r >> 6, o = r & 63; return h * 192 + 128 + (o >> 1) + 32 * (o & 1);
}
template <int MODE> __device__ __forceinline__ void transpose_item(const float* __restrict__ W, int K, int Nsrc, int Nout, const float* __restrict__ gain, bf16_t* WT, int row_off, LAS float* scr, int item, int lane) {
    const int nblk = Nout / 32, kb = item / nblk, nb = item % nblk, k0 = 64 * kb, n0 = 32 * nb;
    const int sc = src_col<MODE>(n0 + (lane & 31));
#pragma unroll 8
    for (int i = 0; i < 32; ++i) { const int kk = 2 * i + (lane >> 5); const float g = gain ? gain[k0 + kk] : 1.0f; scr[kk * 33 + (lane & 31)] = W[(size_t)(k0 + kk) * Nsrc + sc] * g; }
    asm volatile("s_waitcnt lgkmcnt(0)" ::: "memory");
    const int c = lane & 7;
#pragma unroll
    for (int j = 0; j < 4; ++j) { const int n = (lane >> 3) + 8 * j; const LAS float* s = scr + (8 * c) * 33 + n;
        u32x4 o; o.x = cvt_pk_bf16(s[0 * 33], s[1 * 33]); o.y = cvt_pk_bf16(s[2 * 33], s[3 * 33]); o.z = cvt_pk_bf16(s[4 * 33], s[5 * 33]); o.w = cvt_pk_bf16(s[6 * 33], s[7 * 33]);
        *(u32x4*)(WT + (size_t)(row_off + n0 + n) * K + k0 + 8 * c) = o; }
    asm volatile("s_waitcnt lgkmcnt(0)" ::: "memory");
}
__device__ __forceinline__ void phase0(const Params& p, LAS unsigned char* lds, int wave, int lane, int gw, int NGW) {
    LAS float* scr = (LAS float*)(lds + wave * 16384);
    bf16_t* W1T = (bf16_t*)(p.ws + WS_W1T); bf16_t* W2T = (bf16_t*)(p.ws + WS_W2T); bf16_t* W3T = (bf16_t*)(p.ws + WS_W3T);
    bf16_t* W4T = (bf16_t*)(p.ws + WS_W4T); bf16_t* W5T = (bf16_t*)(p.ws + WS_W5T); bf16_t* W6T = (bf16_t*)(p.ws + WS_W6T);
    constexpr int I1 = 32 * 384, I2 = 64 * 64, I3a = 32 * 152, I3b = 32 * 18, I4 = 12 * 192, I5 = 8 * 256, I6 = 64 * 64;
    constexpr int NIT = I1 + I2 + I3a + I3b + I4 + I5 + I6;
    for (int it = gw; it < NIT; it += NGW) {
        int r = it;
        if (r < I1) { transpose_item<0>(p.hg_w_in, 2048, 12288, 12288, p.norm_g, W1T, 0, scr, r, lane); continue; } r -= I1;
        if (r < I2) { transpose_item<0>(p.hg_w_out, 4096, 2048, 2048, nullptr, W2T, 0, scr, r, lane); continue; } r -= I2;
        if (r < I3a) { transpose_item<0>(p.mla_w_in, 2048, 4864, 4864, p.norm_g + 2048, W3T, 0, scr, r, lane); continue; } r -= I3a;
        if (r < I3b) { transpose_item<1>(p.w_kv_down, 2048, 576, 576, p.kv_in_norm_g, W3T, 4864, scr, r, lane); continue; } r -= I3b;
        if (r < I4) { transpose_item<2>(p.mla_w_q_up, 768, 6144, 6144, p.mla_q_norm_g, W4T, 0, scr, r, lane); continue; } r -= I4;
        if (r < I5) { transpose_item<0>(p.w_kv_up, 512, 8192, 8192, p.kv_norm_g, W5T, 0, scr, r, lane); continue; } r -= I5;
        transpose_item<0>(p.mla_w_out, 4096, 2048, 2048, nullptr, W6T, 0, scr, r, lane);
    }
    {
        u32x4* z = (u32x4*)(W3T + (size_t)5440 * 2048);
        for (int i = gw * 64 + lane; i < 192 * 2048 / 8; i += NGW * 64) z[i] = (u32x4){0u, 0u, 0u, 0u};
    }
    bf16_t* XN = (bf16_t*)(p.ws + WS_XN);
    for (int m = gw; m < NTOK; m += NGW) {
        const f32x4* xr = (const f32x4*)(p.x + (size_t)m * 2048) + lane;
        f32x4 v[8]; float s = 0.f;
#pragma unroll
        for (int j = 0; j < 8; ++j) { v[j] = xr[64 * j]; s += (v[j][0] * v[j][0] + v[j][1] * v[j][1]) + (v[j][2] * v[j][2] + v[j][3] * v[j][3]); }
        const float rs = __builtin_amdgcn_rsqf(wave_sum(s) * (1.0f / 2048.0f) + EPS);
        u32x2* o8 = (u32x2*)(XN + (size_t)m * 2048) + lane;
#pragma unroll
        for (int j = 0; j < 8; ++j) { u32x2 w; w.x = cvt_pk_bf16(v[j][0] * rs, v[j][1] * rs); w.y = cvt_pk_bf16(v[j][2] * rs, v[j][3] * rs); o8[64 * j] = w; }
    }
}

__device__ __forceinline__ void hgrn_naive(const Params& p, LAS unsigned char* lds, int tid) {
    if (blockIdx.x >= 64) return;
    const int bh = blockIdx.x, b = bh >> 4, h = bh & 15;
    LAS float* fg = (LAS float*)lds; LAS float* kks = fg + 128; LAS float* qs = kks + 128; LAS float* op = qs + 128; LAS float* red = op + 512;
    const float* F = p.out; const bf16_t* Qh = (const bf16_t*)(p.ws + WS_QH); const bf16_t* VI = (const bf16_t*)(p.ws + WS_VI); bf16_t* GS = (bf16_t*)(p.ws + WS_GS);
    const int v = tid & 255, half = tid >> 8, wave = tid >> 6, lane = tid & 63;
    float S[64];
#pragma unroll
    for (int j = 0; j < 64; ++j) S[j] = 0.f;
    float lb = 0.f;
    if (tid < 128) { const float a = p.hg_lb[h * 128 + tid], bb = p.hg_lb[2048 + h * 128 + tid]; lb = 1.0f / (1.0f + __expf(bb - a)); }
    const float gn = p.hg_g_norm[v];
    for (int t = 0; t < SEQ; ++t) {
        const size_t row = (size_t)b * SEQ + t;
        if (tid < 128) {
            const float f = F[row * 2048 + h * 128 + tid]; const float q = bf2f(Qh[row * 2048 + h * 128 + tid]);
            const float sg = 1.0f / (1.0f + __expf(-f));
            fg[tid] = lb + (1.0f - lb) * sg; kks[tid] = (1.0f - lb) * (1.0f - sg); qs[tid] = q;
        }
        const float iv = bf2f(VI[row * 4096 + h * 256 + v]);
        __syncthreads();
        float o = 0.f;
#pragma unroll
        for (int j = 0; j < 64; ++j) { const int k = half * 64 + j; S[j] = fg[k] * S[j] + kks[k] * iv; o += qs[k] * S[j]; }
        op[half * 256 + v] = o;
        __syncthreads();
        const float of = op[v] + op[256 + v];
        const float sq = wave_sum(of * of);
        if (lane == 0) red[wave] = sq;
        __syncthreads();
        const float tot = (red[0] + red[1]) + (red[2] + red[3]);
        const float rs = __builtin_amdgcn_rsqf(tot * (1.0f / 256.0f) + EPS);
        if (half == 0) { bf16_t* g = GS + row * 4096 + h * 256 + v; const float y = of * rs * gn * bf2f(*g); *g = (bf16_t)(cvt_pk_bf16(y, 0.f) & 0xffffu); }
    }
}

__device__ __forceinline__ float dot2(unsigned a, unsigned b) { return bflo(a) * bflo(b) + bfhi(a) * bfhi(b); }
__device__ __forceinline__ void attn_naive(const Params& p, int gw, int NGW, int lane) {
    const bf16_t* Q = (const bf16_t*)(p.ws + WS_Q); const bf16_t* KN = (const bf16_t*)(p.ws + WS_KN); const bf16_t* KR = (const bf16_t*)(p.ws + WS_KR);
    const bf16_t* V = (const bf16_t*)(p.ws + WS_V); bf16_t* GATE = (bf16_t*)(p.ws + WS_GATE);
    for (int unit = gw; unit < 16384; unit += NGW) {
        const int quar = unit & 3, qblk = (unit >> 2) & 31, bh = unit >> 7, b = bh >> 5, h = bh & 31;
        const int qi = qblk * 64 + lane;
        unsigned qr[96];
        { const u32x4* qp = (const u32x4*)(Q + ((size_t)(bh * 2048 + qi)) * 192);
#pragma unroll
          for (int i = 0; i < 24; ++i) { const u32x4 t = qp[i]; qr[4 * i] = t.x; qr[4 * i + 1] = t.y; qr[4 * i + 2] = t.z; qr[4 * i + 3] = t.w; } }
        float o[32];
#pragma unroll
        for (int d = 0; d < 32; ++d) o[d] = 0.f;
        float mx = -1e30f, l = 0.f;
        const int jmax = qblk * 64 + 63;
        for (int j = 0; j <= jmax; ++j) {
            const u32x4* kp = (const u32x4*)(KN + ((size_t)(bh * 2048 + j)) * 128);
            const u32x4* rp = (const u32x4*)(KR + ((size_t)(b * 2048 + j)) * 64);
            float s = 0.f;
#pragma unroll
            for (int i = 0; i < 96; ++i) asm volatile("" : "+v"(qr[i]));
#pragma unroll
            for (int i = 0; i < 16; ++i) { const u32x4 kv = kp[i]; s += dot2(qr[4 * i], kv.x) + dot2(qr[4 * i + 1], kv.y) + dot2(qr[4 * i + 2], kv.z) + dot2(qr[4 * i + 3], kv.w); if ((i & 3) == 3) asm volatile("" ::: "memory"); }
#pragma unroll
            for (int i = 0; i < 8; ++i) { const u32x4 kv = rp[i]; s += dot2(qr[64 + 4 * i], kv.x) + dot2(qr[64 + 4 * i + 1], kv.y) + dot2(qr[64 + 4 * i + 2], kv.z) + dot2(qr[64 + 4 * i + 3], kv.w); if ((i & 3) == 3) asm volatile("" ::: "memory"); }
            if (j <= qi) {
                if (s > mx) { const float al = __builtin_amdgcn_exp2f(mx - s); l *= al;
#pragma unroll
                    for (int d = 0; d < 32; ++d) o[d] *= al;
                    mx = s; }
                const float pe = __builtin_amdgcn_exp2f(s - mx); l += pe;
                const u32x4* vp = (const u32x4*)(V + ((size_t)(bh * 2048 + j)) * 128 + quar * 32);
#pragma unroll
                for (int i = 0; i < 4; ++i) { const u32x4 vv = vp[i];
                    o[8 * i] += pe * bflo(vv.x); o[8 * i + 1] += pe * bfhi(vv.x); o[8 * i + 2] += pe * bflo(vv.y); o[8 * i + 3] += pe * bfhi(vv.y);
                    o[8 * i + 4] += pe * bflo(vv.z); o[8 * i + 5] += pe * bfhi(vv.z); o[8 * i + 6] += pe * bflo(vv.w); o[8 * i + 7] += pe * bfhi(vv.w); }
            }
        }
        const float il = 1.0f / l;
        u32x4* gp = (u32x4*)(GATE + ((size_t)(b * 2048 + qi)) * 4096 + h * 128 + quar * 32);
#pragma unroll
        for (int i = 0; i < 4; ++i) { const u32x4 g = gp[i]; u32x4 w;
            w.x = cvt_pk_bf16(o[8 * i] * il * bflo(g.x), o[8 * i + 1] * il * bfhi(g.x)); w.y = cvt_pk_bf16(o[8 * i + 2] * il * bflo(g.y), o[8 * i + 3] * il * bfhi(g.y));
            w.z = cvt_pk_bf16(o[8 * i + 4] * il * bflo(g.z), o[8 * i + 5] * il * bfhi(g.z)); w.w = cvt_pk_bf16(o[8 * i + 6] * il * bflo(g.w), o[8 * i + 7] * il * bfhi(g.w));
            gp[i] = w; }
    }
}

typedef short bf16x8 __attribute__((ext_vector_type(8)));
typedef short s16x4 __attribute__((ext_vector_type(4)));
typedef float f32x16 __attribute__((ext_vector_type(16)));
constexpr int AT_KROW = 400, AT_VROW = 320, AT_KB = 64 * AT_KROW, AT_VB = 64 * AT_VROW, AT_STAGE = AT_KB + AT_VB, AT_WSF = 2 * AT_STAGE;
__device__ __forceinline__ s16x4 tr_read(LAS const unsigned char* p) { return __builtin_bit_cast(s16x4, __builtin_amdgcn_ds_read_tr16_b64_v4i16((LAS s16x4*)p)); }
__device__ __forceinline__ void attn_unit(int bh, int qb, const bf16_t* __restrict__ Q, const bf16_t* __restrict__ KN, const bf16_t* __restrict__ KR, const bf16_t* __restrict__ V, bf16_t* GATE,
                                          LAS unsigned char* lds, int tid, int wave, int lane) {
    const int r32 = lane & 31, hi = lane >> 5, b = bh >> 5, h = bh & 31;
    const int q0 = qb * 256, NT = 4 * (qb + 1);
    LAS float* wsf = (LAS float*)(lds + AT_WSF) + wave * 32;
    const int krow = tid >> 4, kc = tid & 15, rrow = tid >> 3, rc = tid & 7;
    const bf16_t* kn_src = KN + ((size_t)(bh * 2048 + krow)) * 128 + kc * 8;
    const bf16_t* kr_src = KR + ((size_t)(b * 2048 + rrow)) * 64 + rc * 8;
    const bf16_t* v_src = V + ((size_t)(bh * 2048 + krow)) * 128 + kc * 8;
    const int kn_dst = krow * AT_KROW + kc * 16, kr_dst = rrow * AT_KROW + 256 + rc * 16, v_dst = AT_KB + krow * AT_VROW + kc * 16;
    u32x4 sk0, sk1, skr, sv0, sv1;
#define AT_LOAD(t) do { const size_t o_ = (size_t)(t) * 64 * 128; sk0 = *(const u32x4*)(kn_src + o_); sk1 = *(const u32x4*)(kn_src + o_ + 32 * 128); skr = *(const u32x4*)(kr_src + (size_t)(t) * 64 * 64); \
        sv0 = *(const u32x4*)(v_src + o_); sv1 = *(const u32x4*)(v_src + o_ + 32 * 128); } while (0)
#define AT_WRITE(bufoff) do { LAS unsigned char* d_ = lds + (bufoff); *(LAS u32x4*)(d_ + kn_dst) = sk0; *(LAS u32x4*)(d_ + kn_dst + 32 * AT_KROW) = sk1; *(LAS u32x4*)(d_ + kr_dst) = skr; \
        *(LAS u32x4*)(d_ + v_dst) = sv0; *(LAS u32x4*)(d_ + v_dst + 32 * AT_VROW) = sv1; } while (0)
    AT_LOAD(0);
    bf16x8 qf[12];
    { const bf16_t* qrow = Q + ((size_t)(bh * 2048 + q0 + wave * 32 + r32)) * 192 + hi * 8;
#pragma unroll
      for (int k = 0; k < 12; ++k) qf[k] = *(const bf16x8*)(qrow + 16 * k); }
    f32x16 o[4];
#pragma unroll
    for (int d = 0; d < 4; ++d)
#pragma unroll
        for (int r = 0; r < 16; ++r) o[d][r] = 0.f;
    float mrun = -1e30f, lrun = 0.f;
    AT_WRITE(0);
    if (NT > 1) AT_LOAD(1);
    asm volatile("s_waitcnt lgkmcnt(0)" ::: "memory"); __builtin_amdgcn_s_barrier(); asm volatile("" ::: "memory");
    const int ka_off = r32 * AT_KROW + hi * 16;
    const int i16 = lane & 15, g1 = (lane >> 4) & 1;
    const int va_off = AT_KB + (4 * hi + (i16 >> 2)) * AT_VROW + (16 * g1 + 4 * (i16 & 3)) * 2;
    const int qloc = 32 * wave + r32;
    for (int t = 0; t < NT; ++t) {
        const int cur = (t & 1) * AT_STAGE;
        const int kvrel = 64 * t - q0;
        if (kvrel <= 32 * wave + 31) {
            LAS const unsigned char* kp = lds + cur + ka_off;
            f32x16 p0, p1;
#pragma unroll
            for (int r = 0; r < 16; ++r) { p0[r] = 0.f; p1[r] = 0.f; }
#pragma unroll
            for (int k = 0; k < 12; ++k) {
                const bf16x8 a0 = *(LAS const bf16x8*)(kp + k * 32), a1 = *(LAS const bf16x8*)(kp + 32 * AT_KROW + k * 32);
                p0 = __builtin_amdgcn_mfma_f32_32x32x16_bf16(a0, qf[k], p0, 0, 0, 0);
                p1 = __builtin_amdgcn_mfma_f32_32x32x16_bf16(a1, qf[k], p1, 0, 0, 0);
                if ((k % 3) == 2) asm volatile("" ::: "memory");
            }
            if (kvrel + 63 > 32 * wave) {
#pragma unroll
                for (int r = 0; r < 16; ++r) { const int kv = kvrel + (r & 3) + 8 * (r >> 2) + 4 * hi;
                    if (kv > qloc) p0[r] = -INFINITY; if (kv + 32 > qloc) p1[r] = -INFINITY; }
            }
            float rm = fmaxf(p0[0], p1[0]);
#pragma unroll
            for (int r = 1; r < 16; ++r) rm = fmaxf(rm, fmaxf(p0[r], p1[r]));
            rm = fmaxf(rm, __shfl_xor(rm, 32));
            if (__any(rm > mrun + 8.0f)) {
                const float mn = fmaxf(mrun, rm), al = __builtin_amdgcn_exp2f(mrun - mn);
                mrun = mn; lrun *= al;
                if (hi == 0) wsf[r32] = al;
                asm volatile("s_waitcnt lgkmcnt(0)" ::: "memory");
#pragma unroll
                for (int g = 0; g < 4; ++g) { const f32x4 a4 = *(LAS const f32x4*)(wsf + 8 * g + 4 * hi);
#pragma unroll
                    for (int d = 0; d < 4; ++d) { o[d][4 * g] *= a4[0]; o[d][4 * g + 1] *= a4[1]; o[d][4 * g + 2] *= a4[2]; o[d][4 * g + 3] *= a4[3]; } }
            }
            float ls = 0.f;
#pragma unroll
            for (int r = 0; r < 16; ++r) { p0[r] = __builtin_amdgcn_exp2f(p0[r] - mrun); p1[r] = __builtin_amdgcn_exp2f(p1[r] - mrun); ls += p0[r] + p1[r]; }
            lrun += ls;
            bf16x8 pa[4];
#pragma unroll
            for (int s2 = 0; s2 < 2; ++s2) {
                u32x4 w0, w1;
                w0.x = cvt_pk_bf16(p0[8 * s2], p0[8 * s2 + 1]); w0.y = cvt_pk_bf16(p0[8 * s2 + 2], p0[8 * s2 + 3]); w0.z = cvt_pk_bf16(p0[8 * s2 + 4], p0[8 * s2 + 5]); w0.w = cvt_pk_bf16(p0[8 * s2 + 6], p0[8 * s2 + 7]);
                w1.x = cvt_pk_bf16(p1[8 * s2], p1[8 * s2 + 1]); w1.y = cvt_pk_bf16(p1[8 * s2 + 2], p1[8 * s2 + 3]); w1.z = cvt_pk_bf16(p1[8 * s2 + 4], p1[8 * s2 + 5]); w1.w = cvt_pk_bf16(p1[8 * s2 + 6], p1[8 * s2 + 7]);
                pa[s2] = __builtin_bit_cast(bf16x8, w0); pa[2 + s2] = __builtin_bit_cast(bf16x8, w1);
            }
            LAS const unsigned char* vp = lds + cur + va_off;
#pragma unroll
            for (int s = 0; s < 4; ++s) {
                const int rb = (16 * (s & 1) + 32 * (s >> 1)) * AT_VROW;
#pragma unroll
                for (int d = 0; d < 4; ++d) {
                    const s16x4 lo = tr_read(vp + rb + d * 64), hh = tr_read(vp + rb + 8 * AT_VROW + d * 64);
                    const bf16x8 vf = (bf16x8){lo[0], lo[1], lo[2], lo[3], hh[0], hh[1], hh[2], hh[3]};
                    o[d] = __builtin_amdgcn_mfma_f32_32x32x16_bf16(pa[s], vf, o[d], 0, 0, 0);
                }
                asm volatile("" ::: "memory");
            }
        }
        if (t + 1 < NT) AT_WRITE(((t + 1) & 1) * AT_STAGE);
        asm volatile("s_waitcnt lgkmcnt(0)" ::: "memory"); __builtin_amdgcn_s_barrier(); asm volatile("" ::: "memory");
        if (t + 2 < NT) AT_LOAD(t + 2);
    }
    lrun += __shfl_xor(lrun, 32);
    if (hi == 0) wsf[r32] = 1.0f / lrun;
    asm volatile("s_waitcnt lgkmcnt(0)" ::: "memory");
#pragma unroll
    for (int g = 0; g < 4; ++g) {
        const f32x4 li = *(LAS const f32x4*)(wsf + 8 * g + 4 * hi);
#pragma unroll
        for (int i = 0; i < 4; ++i) {
            const int row = q0 + 32 * wave + 8 * g + 4 * hi + i;
            bf16_t* gp = GATE + ((size_t)(b * 2048 + row)) * 4096 + h * 128 + r32;
#pragma unroll
            for (int d = 0; d < 4; ++d) { const float y = o[d][4 * g + i] * li[i] * bf2f(gp[32 * d]); gp[32 * d] = (bf16_t)(cvt_pk_bf16(y, 0.f) & 0xffffu); }
        }
    }
#undef AT_LOAD
#undef AT_WRITE
}
__device__ __forceinline__ void attn_phase(const Params& p, LAS unsigned char* lds, int tid, int wave, int lane) {
    const bf16_t* Q = (const bf16_t*)(p.ws + WS_Q); const bf16_t* KN = (const bf16_t*)(p.ws + WS_KN); const bf16_t* KR = (const bf16_t*)(p.ws + WS_KR);
    const bf16_t* V = (const bf16_t*)(p.ws + WS_V); bf16_t* GATE = (bf16_t*)(p.ws + WS_GATE);
    for (int pi = blockIdx.x; pi < 512; pi += gridDim.x) {
        const int bh = pi >> 2, pp = pi & 3;
        attn_unit(bh, 7 - pp, Q, KN, KR, V, GATE, lds, tid, wave, lane);
        attn_unit(bh, pp, Q, KN, KR, V, GATE, lds, tid, wave, lane);
    }
}

__device__ __forceinline__ void final_norm(const Params& p, int gw, int NGW, int lane) {
    const float* ss2 = (const float*)(p.ws + WS_SS2);
    for (int m = gw; m < NTOK; m += NGW) {
        const float t = wave_sum(lane < 32 ? ss2[(size_t)m * 32 + lane] : 0.f);
        const float rs = __builtin_amdgcn_rsqf(t * (1.0f / 2048.0f) + EPS);
        f32x4* xr = (f32x4*)(p.out + (size_t)m * 2048) + lane; const f32x4* gr = (const f32x4*)p.final_norm_g + lane;
#pragma unroll
        for (int j = 0; j < 8; ++j) { const f32x4 v = xr[64 * j], g = gr[64 * j]; xr[64 * j] = v * rs * g; }
    }
}

__global__ void __launch_bounds__(512) yoco_fwd(Params p) {
    extern __shared__ __attribute__((aligned(16))) unsigned char lds_raw[];
    LAS unsigned char* lds = (LAS unsigned char*)lds_raw;
    cg::grid_group grid = cg::this_grid();
    const int wave = __builtin_amdgcn_readfirstlane(threadIdx.x >> 6);
    const int G = gridDim.x, gw = blockIdx.x * 8 + wave, NGW = G * 8;
    unsigned char* ws = p.ws;
    phase0(p, lds, wave, pg8::pg8_lane_id(), gw, NGW);
    grid.sync();
    { pg8::Gemm g{(const bf16_t*)(ws + WS_XN), (const bf16_t*)(ws + WS_W1T), NTOK, 12288, 2048}; pg8::StaticOrder S; S.init(NTOK, 12288, G, (int)blockIdx.x);
      EpiG1 E{(bf16_t*)(ws + WS_QH), p.out, (bf16_t*)(ws + WS_VI), (bf16_t*)(ws + WS_GS)};
      pg8::gemm_phase<EpiG1, pg8::StaticOrder, PG8_ALIGN, PG8_SP2>(lds, g, S, E, wave); }
    grid.sync();
    hgrn_naive(p, lds, wave * 64 + pg8::pg8_lane_id());
    grid.sync();
    { pg8::Gemm g{(const bf16_t*)(ws + WS_GS), (const bf16_t*)(ws + WS_W2T), NTOK, 2048, 4096}; pg8::StaticOrder S; S.init(NTOK, 2048, G, (int)blockIdx.x);
      EpiRes<true> E{p.x, p.out, (bf16_t*)(ws + WS_H1B), (float*)(ws + WS_SS1)};
      pg8::gemm_phase<EpiRes<true>, pg8::StaticOrder, PG8_ALIGN, PG8_SP2>(lds, g, S, E, wave); }
    grid.sync();
    { pg8::Gemm g{(const bf16_t*)(ws + WS_H1B), (const bf16_t*)(ws + WS_W3T), NTOK, 5632, 2048}; pg8::StaticOrder S; S.init(NTOK, 5632, G, (int)blockIdx.x);
      EpiG3 E{(const float*)(ws + WS_SS1), (bf16_t*)(ws + WS_CQ), (bf16_t*)(ws + WS_GATE), (bf16_t*)(ws + WS_C), (bf16_t*)(ws + WS_KR), (float*)(ws + WS_SSQ), (float*)(ws + WS_SSC)};
      pg8::gemm_phase<EpiG3, pg8::StaticOrder, PG8_ALIGN, PG8_SP2>(lds, g, S, E, wave); }
    grid.sync();
    { pg8::Gemm g{(const bf16_t*)(ws + WS_CQ), (const bf16_t*)(ws + WS_W4T), NTOK, 6144, 768}; pg8::StaticOrder S; S.init(NTOK, 6144, G, (int)blockIdx.x);
      EpiQ E{(const float*)(ws + WS_SSQ), (bf16_t*)(ws + WS_Q)};
      pg8::gemm_phase<EpiQ, pg8::StaticOrder, PG8_ALIGN, PG8_SP2>(lds, g, S, E, wave); }
    { pg8::Gemm g{(const bf16_t*)(ws + WS_C), (const bf16_t*)(ws + WS_W5T), NTOK, 8192, 512}; pg8::StaticOrder S; S.init(NTOK, 8192, G, (int)blockIdx.x);
      EpiKV E{(const float*)(ws + WS_SSC), (bf16_t*)(ws + WS_KN), (bf16_t*)(ws + WS_V)};
      pg8::gemm_phase<EpiKV, pg8::StaticOrder, PG8_ALIGN, PG8_SP2>(lds, g, S, E, wave); }
    grid.sync();
    { const int l_ = pg8::pg8_lane_id(); attn_phase(p, lds, wave * 64 + l_, wave, l_); }
    grid.sync();
    { pg8::Gemm g{(const bf16_t*)(ws + WS_GATE), (const bf16_t*)(ws + WS_W6T), NTOK, 2048, 4096}; pg8::StaticOrder S; S.init(NTOK, 2048, G, (int)blockIdx.x);
      EpiRes<false> E{p.out, p.out, nullptr, (float*)(ws + WS_SS2)};
      pg8::gemm_phase<EpiRes<false>, pg8::StaticOrder, PG8_ALIGN, PG8_SP2>(lds, g, S, E, wave); }
    grid.sync();
    final_norm(p, gw, NGW, pg8::pg8_lane_id());
}

extern "C" void kernel_launch(void* const* d_in, const int* in_sizes, int n_in, void* d_out, int out_size, void* d_ws, size_t ws_size, hipStream_t stream) {
    static int grid = 0;
    if (grid == 0) {
        if (n_in != 15 || out_size != NTOK * DM || ws_size < WS_NEED) { fprintf(stderr, "kernel_launch: unexpected shapes (n_in %d out %d ws %zu)\n", n_in, out_size, ws_size); grid = -1; return; }
        int dev = 0, cus = 0, per_cu = 0;
        hipGetDevice(&dev); hipDeviceGetAttribute(&cus, hipDeviceAttributeMultiprocessorCount, dev);
        hipFuncSetAttribute((const void*)yoco_fwd, hipFuncAttributeMaxDynamicSharedMemorySize, LDS_BYTES);
        hipOccupancyMaxActiveBlocksPerMultiprocessor(&per_cu, (const void*)yoco_fwd, 512, LDS_BYTES);
        if (per_cu < 1) per_cu = 1;
        (void)hipGetLastError();
        grid = cus * per_cu;
    }
    if (grid < 0) return;
    Params p{};
    p.x = (const float*)d_in[0]; p.norm_g = (const float*)d_in[1]; p.hg_w_in = (const float*)d_in[2]; p.hg_g_norm = (const float*)d_in[3]; p.hg_w_out = (const float*)d_in[4];
    p.hg_lb = (const float*)d_in[5]; p.kv_in_norm_g = (const float*)d_in[6]; p.w_kv_down = (const float*)d_in[7]; p.kv_norm_g = (const float*)d_in[8]; p.w_kv_up = (const float*)d_in[9];
    p.mla_w_in = (const float*)d_in[10]; p.mla_q_norm_g = (const float*)d_in[11]; p.mla_w_q_up = (const float*)d_in[12]; p.mla_w_out = (const float*)d_in[13]; p.final_norm_g = (const float*)d_in[14];
    p.out = (float*)d_out; p.ws = (unsigned char*)d_ws;
    void* args[] = {&p};
    hipError_t e = hipLaunchCooperativeKernel((const void*)yoco_fwd, dim3(grid), dim3(512), args, LDS_BYTES, stream);
    if (e != hipSuccess) fprintf(stderr, "cooperative launch failed: %s (grid %d)\n", hipGetErrorString(e), grid);
}
```

```cpp
#include <hip/hip_runtime.h>
#include <hip/hip_cooperative_groups.h>
#include <cstdio>
#include <cstdint>
namespace cg = cooperative_groups;
namespace pg8 {
#define PG8_LAS __attribute__((address_space(3)))
typedef unsigned short bf16_t;
typedef short bf16x8 __attribute__((ext_vector_type(8)));
typedef float f32x4 __attribute__((ext_vector_type(4)));
typedef unsigned u32x4 __attribute__((ext_vector_type(4)));
constexpr int BM = 256, BK = 64, HALF = 128, HTB = HALF * BK * 2  , STAGE_BYTES = 8 * HTB, NXCD = 8, WGM = 8;

__host__ __device__ __forceinline__ int lds_byte(int r, int c) { const int st = (r >> 4) * 2 + (c >> 5), rr = r & 15, cc = c & 31, ob = rr * 64 + cc * 2; return st * 1024 + (ob ^ (((ob >> 9) & 1) << 5)); }
__host__ __device__ __forceinline__ void stage_rc(int b, int& R, int& C) { const int st = b / 1024, sb = b % 1024, swz = sb ^ (((sb >> 9) & 1) << 5); R = (st >> 1) * 16 + swz / 64; C = (st & 1) * 32 + (swz % 64) / 2; }
__host__ __device__ __forceinline__ int perm32(int rho) { const int n = rho >> 4, i = rho & 15; return 8 * (i >> 2) + 4 * n + (i & 3); }

struct Unit { int pm, pn; };
struct Gemm { const bf16_t* A; const bf16_t* Bt; int M, N, K; };

struct StaticOrder {
    int nM, nN, nwg, G, c;
    __host__ __device__ void init(int M, int N, int G_, int c_) { nM = M / BM; nN = N / BM; nwg = nM * nN; G = G_; c = c_; }
    __host__ __device__ bool next(int i, Unit& u) const {
        const long L = (long)i * G + c; if (L >= nwg) return false;
        int wgid = (int)L; { const int q = nwg / NXCD, r = nwg % NXCD, xcd = wgid % NXCD, off = wgid / NXCD; wgid = (xcd < r ? xcd * (q + 1) : r * (q + 1) + (xcd - r) * q) + off; }
        const int nig = WGM * nN, gid = wgid / nig, fm = gid * WGM, gsz = (nM - fm) < WGM ? (nM - fm) : WGM;
        u.pm = fm + ((wgid % nig) % gsz); u.pn = (wgid % nig) / gsz; return true;
    }
    __device__ __forceinline__ void a_ready(const Unit&) const {}
    __device__ __forceinline__ void done(const Unit&) const {}
};

__device__ __forceinline__ unsigned cvt_pk_bf16(float lo, float hi) { unsigned r; asm volatile("v_cvt_pk_bf16_f32 %0, %1, %2" : "=v"(r) : "v"(lo), "v"(hi)); return r; }
__device__ __forceinline__ int pg8_lane_id() { int l; asm volatile("v_mbcnt_lo_u32_b32 %0, -1, 0\n\tv_mbcnt_hi_u32_b32 %0, -1, %0" : "=v"(l)); return l; }
template <class Epi, class Sched, bool ALIGN_EPI = false, bool SP2 = false>
__device__ __forceinline__ void gemm_phase(PG8_LAS unsigned char* lds, const Gemm g, const Sched& S, const Epi& E, int wave_id) {
    const int wid = wave_id, lane = pg8_lane_id(), tid = wid * 64 + lane, wr = wid >> 2, wc = wid & 3, fr = lane & 15, fq = lane >> 4;
    const int K = g.K, nt = K / BK;
    unsigned voffA[2], voffB[2];
#pragma unroll
    for (int i = 0; i < 2; ++i) { int R, C; stage_rc(tid * 16 + i * 8192, R, C); const int Rb = Epi::PERM ? ((R & ~31) + perm32(R & 31)) : R;
        voffA[i] = (unsigned)(R * K + C) * 2u; voffB[i] = (unsigned)(Rb * K + C) * 2u; }
    const size_t kstep = (size_t)(BK * 2);
    const size_t hstep = (size_t)HALF * K * 2;
    const size_t tstep = 2 * hstep;
    const unsigned ldsw = (unsigned)wid * 1024u;
    const int aoff = lds_byte(wr * 64 + fr, fq * 8), boff = lds_byte(wc * 32 + fr, fq * 8);
#define PG8_SA(b, h) (((b) * 2 + (h)) * HTB)
#define PG8_SB(b, h) ((4 + (b) * 2 + (h)) * HTB)
#define PG8_STAGE(bufoff, gbase, voff) do { _Pragma("unroll") for (int _i = 0; _i < 2; ++_i) \
        __builtin_amdgcn_global_load_lds((const unsigned*)((const char*)(gbase) + (voff)[_i]), (PG8_LAS unsigned*)(lds + (bufoff) + ldsw + _i * 8192), 16, 0, 0); } while (0)
#define PG8_LDA(dst, b, h) do { _Pragma("unroll") for (int m = 0; m < 4; ++m) _Pragma("unroll") for (int k = 0; k < 2; ++k) dst[m][k] = *(const PG8_LAS bf16x8*)(lds + PG8_SA(b, h) + aoff + m * 2048 + k * 1024); } while (0)
#define PG8_LDB(dst, b, h) do { _Pragma("unroll") for (int n = 0; n < 2; ++n) _Pragma("unroll") for (int k = 0; k < 2; ++k) dst[n][k] = *(const PG8_LAS bf16x8*)(lds + PG8_SB(b, h) + boff + n * 2048 + k * 1024); } while (0)
#define PG8_MMA(ai, bj, At, Bt) do { __builtin_amdgcn_s_setprio(1); _Pragma("unroll") for (int m = 0; m < 4; ++m) _Pragma("unroll") for (int n = 0; n < 2; ++n) _Pragma("unroll") for (int k = 0; k < 2; ++k) \
        acc[ai][bj][m][n] = __builtin_amdgcn_mfma_f32_16x16x32_bf16(Bt[n][k], At[m][k], acc[ai][bj][m][n], 0, 0, 0); __builtin_amdgcn_s_setprio(0); } while (0)
#define PG8_WAIT_V(n) asm volatile("s_waitcnt vmcnt(" #n ")" ::: "memory")
#define PG8_WAIT_L(n) asm volatile("s_waitcnt lgkmcnt(" #n ")" ::: "memory")
#define PG8_BAR __builtin_amdgcn_s_barrier()
#define PG8_SCHED __builtin_amdgcn_sched_barrier(0)
    Unit cur, nxt; int ui = 0;
    if (!S.next(0, cur)) return;
    f32x4 acc[2][2][4][2];
#pragma unroll
    for (int a = 0; a < 2; ++a)
#pragma unroll
        for (int b = 0; b < 2; ++b)
#pragma unroll
            for (int m = 0; m < 4; ++m)
#pragma unroll
                for (int n = 0; n < 2; ++n) acc[a][b][m][n] = (f32x4){0.f, 0.f, 0.f, 0.f};
    bf16x8 At[4][2], B0[2][2], B1[2][2];
    const char* cA = (const char*)g.A + (size_t)cur.pm * tstep; const char* cB = (const char*)g.Bt + (size_t)cur.pn * tstep;
    S.a_ready(cur);
    if constexpr (SP2) {
        PG8_STAGE(PG8_SB(0, 0), cB, voffB); PG8_STAGE(PG8_SB(0, 1), cB + hstep, voffB); PG8_STAGE(PG8_SA(0, 0), cA, voffA); PG8_STAGE(PG8_SA(0, 1), cA + hstep, voffA);
        if (wr == 1) PG8_BAR;
        PG8_WAIT_V(2); PG8_BAR;
        PG8_STAGE(PG8_SB(1, 0), cB + kstep, voffB); PG8_STAGE(PG8_SA(1, 0), cA + kstep, voffA); PG8_STAGE(PG8_SB(1, 1), cB + hstep + kstep, voffB);
        PG8_WAIT_V(6); PG8_BAR;
    } else {
        PG8_STAGE(PG8_SB(0, 0), cB, voffB); PG8_STAGE(PG8_SA(0, 0), cA, voffA); PG8_STAGE(PG8_SB(0, 1), cB + hstep, voffB); PG8_STAGE(PG8_SA(0, 1), cA + hstep, voffA);
        if (wr == 1) PG8_BAR;
        PG8_WAIT_V(4); PG8_BAR;
        PG8_STAGE(PG8_SB(1, 0), cB + kstep, voffB); PG8_STAGE(PG8_SA(1, 0), cA + kstep, voffA); PG8_STAGE(PG8_SB(1, 1), cB + hstep + kstep, voffB);
        PG8_WAIT_V(6); PG8_BAR;
    }
    for (;;) {
        const bool has_next = S.next(ui + 1, nxt);
        const char* nA = has_next ? (const char*)g.A + (size_t)nxt.pm * tstep : cA; const char* nB = has_next ? (const char*)g.Bt + (size_t)nxt.pn * tstep : cB;
        for (int t = 0; t < nt; t += 2) {
            const bool last = (t == nt - 2);
            const char* a1 = cA + (size_t)(t + 1) * kstep;
            const char* a2 = last ? nA : cA + (size_t)(t + 2) * kstep; const char* b2 = last ? nB : cB + (size_t)(t + 2) * kstep;
            const char* a3 = a2 + kstep; const char* b3 = b2 + kstep;
            if (last && has_next) S.a_ready(nxt);
            if constexpr (SP2) {
            PG8_LDB(B0, 0, 0); PG8_LDB(B1, 0, 1); PG8_SCHED; PG8_LDA(At, 0, 0); PG8_STAGE(PG8_SA(1, 1), a1 + hstep, voffA);
            PG8_WAIT_V(8); PG8_WAIT_L(0); PG8_BAR; PG8_MMA(0, 0, At, B0); PG8_MMA(0, 1, At, B1); PG8_BAR; PG8_SCHED;
            PG8_LDA(At, 0, 1); PG8_STAGE(PG8_SB(0, 0), b2, voffB); PG8_STAGE(PG8_SB(0, 1), b2 + hstep, voffB); PG8_STAGE(PG8_SA(0, 0), a2, voffA);
            PG8_WAIT_V(8); PG8_WAIT_L(0); PG8_BAR; PG8_MMA(1, 0, At, B0); PG8_MMA(1, 1, At, B1); PG8_BAR; PG8_SCHED;
            PG8_LDB(B0, 1, 0); PG8_LDB(B1, 1, 1); PG8_SCHED; PG8_LDA(At, 1, 0); PG8_STAGE(PG8_SA(0, 1), a2 + hstep, voffA);
            PG8_WAIT_V(8); PG8_WAIT_L(0); PG8_BAR; PG8_MMA(0, 0, At, B0); PG8_MMA(0, 1, At, B1); PG8_BAR; PG8_SCHED;
            PG8_LDA(At, 1, 1); PG8_STAGE(PG8_SB(1, 0), b3, voffB); PG8_STAGE(PG8_SB(1, 1), b3 + hstep, voffB); PG8_STAGE(PG8_SA(1, 0), a3, voffA);
            PG8_WAIT_V(8); PG8_WAIT_L(0); PG8_BAR; PG8_MMA(1, 0, At, B0); PG8_MMA(1, 1, At, B1); PG8_BAR; PG8_SCHED;
            } else {
            PG8_LDB(B0, 0, 0); PG8_SCHED; PG8_LDA(At, 0, 0); PG8_STAGE(PG8_SA(1, 1), a1 + hstep, voffA);
            PG8_WAIT_L(8); PG8_BAR; PG8_WAIT_L(0); PG8_MMA(0, 0, At, B0); PG8_BAR; PG8_SCHED;
            PG8_LDB(B1, 0, 1); PG8_STAGE(PG8_SB(0, 0), b2, voffB);
            PG8_BAR; PG8_WAIT_L(0); PG8_MMA(0, 1, At, B1); PG8_BAR;
            PG8_LDA(At, 0, 1); PG8_STAGE(PG8_SA(0, 0), a2, voffA);
            PG8_BAR; PG8_WAIT_L(0); PG8_MMA(1, 0, At, B0); PG8_BAR; PG8_SCHED;
            PG8_STAGE(PG8_SB(0, 1), b2 + hstep, voffB);
            PG8_WAIT_V(6); PG8_BAR; PG8_MMA(1, 1, At, B1); PG8_BAR;
            PG8_LDB(B0, 1, 0); PG8_SCHED; PG8_LDA(At, 1, 0); PG8_STAGE(PG8_SA(0, 1), a2 + hstep, voffA);
            PG8_WAIT_L(8); PG8_BAR; PG8_WAIT_L(0); PG8_MMA(0, 0, At, B0); PG8_BAR; PG8_SCHED;
            PG8_LDB(B1, 1, 1); PG8_STAGE(PG8_SB(1, 0), b3, voffB);
            PG8_BAR; PG8_WAIT_L(0); PG8_MMA(0, 1, At, B1); PG8_BAR;
            PG8_LDA(At, 1, 1); PG8_STAGE(PG8_SA(1, 0), a3, voffA);
            PG8_BAR; PG8_WAIT_L(0); PG8_MMA(1, 0, At, B0); PG8_BAR; PG8_SCHED;
            PG8_STAGE(PG8_SB(1, 1), b3 + hstep, voffB);
            PG8_WAIT_V(6); PG8_BAR; PG8_MMA(1, 1, At, B1); PG8_BAR;
            }
        }
        if constexpr (ALIGN_EPI) { if (wr == 0) PG8_BAR; }
        if constexpr (!Epi::AFTER_DRAIN) { E(acc, cur, wr, wc, fr, fq); S.done(cur); }
        if (!has_next) break;
#pragma unroll
        for (int a = 0; a < 2; ++a)
#pragma unroll
            for (int b = 0; b < 2; ++b)
#pragma unroll
                for (int m = 0; m < 4; ++m)
#pragma unroll
                    for (int n = 0; n < 2; ++n) acc[a][b][m][n] = (f32x4){0.f, 0.f, 0.f, 0.f};
        cur = nxt; cA = nA; cB = nB; ++ui;
        if constexpr (ALIGN_EPI) { if (wr == 1) PG8_BAR; }
    }
    PG8_WAIT_V(0);
    if constexpr (!ALIGN_EPI) { if (wr == 0) PG8_BAR; }
    PG8_BAR;
    if constexpr (Epi::AFTER_DRAIN) { E.fused(acc, cur, wr, wc, fr, fq, lds, wid, lane); S.done(cur); }
#undef PG8_SA
#undef PG8_SB
#undef PG8_STAGE
#undef PG8_LDA
#undef PG8_LDB
#undef PG8_MMA
#undef PG8_WAIT_V
#undef PG8_WAIT_L
#undef PG8_BAR
#undef PG8_SCHED
}
}
#define PG8_ALIGN true
#define PG8_SP2 true
#define LAS __attribute__((address_space(3)))
typedef unsigned short bf16_t;
typedef float f32x4 __attribute__((ext_vector_type(4)));
typedef unsigned u32x4 __attribute__((ext_vector_type(4)));
typedef unsigned u32x2 __attribute__((ext_vector_type(2)));
using pg8::cvt_pk_bf16;
constexpr int NTOK = 8192, DM = 2048, SEQ = 2048, DI = 4096;
constexpr float EPS = 1e-6f;
constexpr size_t MiB = 1u << 20;
constexpr size_t WS_W2T = 1 * MiB, WS_W3T = 17 * MiB, WS_W4T = 39 * MiB, WS_W5T = 48 * MiB, WS_W6T = 56 * MiB;
constexpr size_t WS_QH = 72 * MiB, WS_VI = 104 * MiB, WS_GS = 168 * MiB, WS_ST = 232 * MiB, WS_W1T = 232 * MiB, WS_XN = 280 * MiB;
constexpr size_t WS_H1B = 72 * MiB, WS_Q = 72 * MiB, WS_KN = 168 * MiB, WS_GATE = 232 * MiB, WS_CQ = 296 * MiB, WS_C = 308 * MiB, WS_KR = 316 * MiB, WS_V = 317 * MiB;
constexpr size_t WS_SS1 = 381 * MiB, WS_SSQ = 382 * MiB, WS_SSC = 382 * MiB + 512 * 1024, WS_SS2 = 383 * MiB, WS_NEED = 384 * MiB;
constexpr int LDS_BYTES = 147456;
constexpr float QSCALE = 0.07216878364870322f * 1.4426950408889634f;

struct Params {
    const float* x; const float* norm_g; const float* hg_w_in; const float* hg_g_norm; const float* hg_w_out; const float* hg_lb;
    const float* kv_in_norm_g; const float* w_kv_down; const float* kv_norm_g; const float* w_kv_up; const float* mla_w_in; const float* mla_q_norm_g;
    const float* mla_w_q_up; const float* mla_w_out; const float* final_norm_g;
    float* out; unsigned char* ws;
};

__device__ __forceinline__ float bf2f(bf16_t v) { return __uint_as_float((unsigned)v << 16); }
__device__ __forceinline__ float bflo(unsigned u) { return __uint_as_float(u << 16); }
__device__ __forceinline__ float bfhi(unsigned u) { return __uint_as_float(u & 0xffff0000u); }
__device__ __forceinline__ float silu_f(float v) { return v * __builtin_amdgcn_rcpf(1.0f + __builtin_amdgcn_exp2f(-1.4426950408889634f * v)); }
__device__ __forceinline__ float wave_sum(float v) {
#pragma unroll
    for (int o = 1; o < 64; o <<= 1) v += __shfl_xor(v, o);
    return v;
}
__device__ __forceinline__ void store8_bf16(bf16_t* p, const f32x4& a, const f32x4& b) {
    u32x4 w; w.x = cvt_pk_bf16(a[0], a[1]); w.y = cvt_pk_bf16(a[2], a[3]); w.z = cvt_pk_bf16(b[0], b[1]); w.w = cvt_pk_bf16(b[2], b[3]);
    *(u32x4*)p = w;
}
__device__ __forceinline__ void rope8(f32x4& a, f32x4& b, int pos, int j0) {
    float v[8] = {a[0], a[1], a[2], a[3], b[0], b[1], b[2], b[3]};
#pragma unroll
    for (int p = 0; p < 4; ++p) {
        const float inv = __builtin_amdgcn_exp2f(-(float)(j0 + p) * 0.41524101186092029f);
        float rev = (float)pos * inv * 0.15915494309189535f; rev = rev - floorf(rev);
        const float c = __builtin_amdgcn_cosf(rev), s = __builtin_amdgcn_sinf(rev);
        const float x1 = v[2 * p], x2 = v[2 * p + 1];
        v[2 * p] = x1 * c - x2 * s; v[2 * p + 1] = x2 * c + x1 * s;
    }
    a = (f32x4){v[0], v[1], v[2], v[3]}; b = (f32x4){v[4], v[5], v[6], v[7]};
}

typedef const f32x4 (&AccRef)[2][2][4][2];
struct EpiG1 {
    static constexpr bool PERM = true, AFTER_DRAIN = false;
    bf16_t* Qh; float* F; bf16_t* VI; bf16_t* GS;
    __device__ __forceinline__ void operator()(AccRef acc, const pg8::Unit& u, int wr, int wc, int fr, int fq) const {
        const int pn = u.pn;
#pragma unroll
        for (int ai = 0; ai < 2; ++ai)
#pragma unroll
            for (int m = 0; m < 4; ++m) {
                const size_t row = (size_t)(u.pm * 256 + ai * 128 + wr * 64 + m * 16 + fr);
#pragma unroll
                for (int bj = 0; bj < 2; ++bj) {
                    const int col = pn * 256 + bj * 128 + wc * 32 + 8 * fq;
                    f32x4 a = acc[ai][bj][m][0], b = acc[ai][bj][m][1];
                    if (pn < 8) store8_bf16(Qh + row * 2048 + col, a, b);
                    else if (pn < 16) { float* o = F + row * 2048 + (col - 2048); *(f32x4*)o = a; *(f32x4*)(o + 4) = b; }
                    else if (pn < 32) store8_bf16(VI + row * 4096 + (col - 4096), a, b);
                    else {
#pragma unroll
                        for (int j = 0; j < 4; ++j) { a[j] = silu_f(a[j]); b[j] = silu_f(b[j]); }
                        store8_bf16(GS + row * 4096 + (col - 8192), a, b);
                    }
                }
            }
    }
};
template <bool WB> struct EpiRes {
    static constexpr bool PERM = true, AFTER_DRAIN = false;
    const float* base; float* out; bf16_t* outb; float* ss;
    __device__ __forceinline__ void operator()(AccRef acc, const pg8::Unit& u, int wr, int wc, int fr, int fq) const {
#pragma unroll
        for (int ai = 0; ai < 2; ++ai)
#pragma unroll
            for (int m = 0; m < 4; ++m) {
                const size_t row = (size_t)(u.pm * 256 + ai * 128 + wr * 64 + m * 16 + fr);
                float s = 0.f;
#pragma unroll
                for (int bj = 0; bj < 2; ++bj) {
                    const int col = u.pn * 256 + bj * 128 + wc * 32 + 8 * fq;
                    const size_t off = row * 2048 + col;
                    f32x4 a = acc[ai][bj][m][0] + *(const f32x4*)(base + off), b = acc[ai][bj][m][1] + *(const f32x4*)(base + off + 4);
                    *(f32x4*)(out + off) = a; *(f32x4*)(out + off + 4) = b;
                    if (WB) store8_bf16(outb + off, a, b);
                    s += (a[0] * a[0] + a[1] * a[1]) + (a[2] * a[2] + a[3] * a[3]) + (b[0] * b[0] + b[1] * b[1]) + (b[2] * b[2] + b[3] * b[3]);
                }
                s += __shfl_xor(s, 16); s += __shfl_xor(s, 32);
                if (fq == 0) ss[row * 32 + u.pn * 4 + wc] = s;
            }
    }
};
struct EpiG3 {
    static constexpr bool PERM = true, AFTER_DRAIN = false;
    const float* ss1; bf16_t* CQ; bf16_t* GATE; bf16_t* C; bf16_t* KR; float* ssq; float* ssc;
    __device__ __forceinline__ void operator()(AccRef acc, const pg8::Unit& u, int wr, int wc, int fr, int fq) const {
        const int pn = u.pn;
#pragma unroll
        for (int ai = 0; ai < 2; ++ai)
#pragma unroll
            for (int m = 0; m < 4; ++m) {
                const size_t row = (size_t)(u.pm * 256 + ai * 128 + wr * 64 + m * 16 + fr);
                float t = 0.f;
                { const f32x4* sp = (const f32x4*)(ss1 + row * 32);
#pragma unroll
                  for (int i = 0; i < 8; ++i) { const f32x4 q = sp[i]; t += (q[0] + q[1]) + (q[2] + q[3]); } }
                const float rs = __builtin_amdgcn_rsqf(t * (1.0f / 2048.0f) + EPS);
                float s = 0.f;
#pragma unroll
                for (int bj = 0; bj < 2; ++bj) {
                    const int lc = bj * 128 + wc * 32 + 8 * fq;
                    f32x4 a = acc[ai][bj][m][0] * rs, b = acc[ai][bj][m][1] * rs;
                    if (pn < 3) { store8_bf16(CQ + row * 768 + pn * 256 + lc, a, b); }
                    else if (pn < 19) {
#pragma unroll
                        for (int j = 0; j < 4; ++j) { a[j] = silu_f(a[j]); b[j] = silu_f(b[j]); }
                        store8_bf16(GATE + row * 4096 + (pn - 3) * 256 + lc, a, b);
                    } else if (pn < 21) { store8_bf16(C + row * 512 + (pn - 19) * 256 + lc, a, b); }
                    else if (bj == 0 && wc < 2) { rope8(a, b, (int)(row & 2047), wc * 16 + 4 * fq); store8_bf16(KR + row * 64 + lc, a, b); }
                    s += (a[0] * a[0] + a[1] * a[1]) + (a[2] * a[2] + a[3] * a[3]) + (b[0] * b[0] + b[1] * b[1]) + (b[2] * b[2] + b[3] * b[3]);
                }
                s += __shfl_xor(s, 16); s += __shfl_xor(s, 32);
                if (fq == 0) { if (pn < 3) ssq[row * 16 + pn * 4 + wc] = s; else if (pn == 19 || pn == 20) ssc[row * 8 + (pn - 19) * 4 + wc] = s; }
            }
    }
};
struct EpiQ {
    static constexpr bool PERM = true, AFTER_DRAIN = false;
    const float* ssq; bf16_t* Q;
    __device__ __forceinline__ void operator()(AccRef acc, const pg8::Unit& u, int wr, int wc, int fr, int fq) const {
        const int pn = u.pn;
#pragma unroll
        for (int ai = 0; ai < 2; ++ai)
#pragma unroll
            for (int m = 0; m < 4; ++m) {
                const int row = u.pm * 256 + ai * 128 + wr * 64 + m * 16 + fr;
                const f32x4* sp = (const f32x4*)(ssq + (size_t)row * 16);
                const f32x4 q0 = sp[0], q1 = sp[1], q2 = sp[2];
                const float t = ((q0[0] + q0[1]) + (q0[2] + q0[3])) + ((q1[0] + q1[1]) + (q1[2] + q1[3])) + ((q2[0] + q2[1]) + (q2[2] + q2[3]));
                const float rs = __builtin_amdgcn_rsqf(t * (1.0f / 768.0f) + EPS) * QSCALE;
                const int b_ = row >> 11, s_ = row & 2047;
#pragma unroll
                for (int bj = 0; bj < 2; ++bj) {
                    f32x4 a = acc[ai][bj][m][0] * rs, b = acc[ai][bj][m][1] * rs;
                    if (pn < 16) { const int h = pn * 2 + bj; store8_bf16(Q + ((size_t)((b_ * 32 + h) * 2048 + s_)) * 192 + wc * 32 + 8 * fq, a, b); }
                    else { const int h = (pn - 16) * 4 + bj * 2 + (wc >> 1), off = (wc & 1) * 32 + 8 * fq;
                        rope8(a, b, s_, off >> 1); store8_bf16(Q + ((size_t)((b_ * 32 + h) * 2048 + s_)) * 192 + 128 + off, a, b); }
                }
            }
    }
};
struct EpiKV {
    static constexpr bool PERM = true, AFTER_DRAIN = false;
    const float* ssc; bf16_t* KN; bf16_t* V;
    __device__ __forceinline__ void operator()(AccRef acc, const pg8::Unit& u, int wr, int wc, int fr, int fq) const {
        const int h = u.pn;
#pragma unroll
        for (int ai = 0; ai < 2; ++ai)
#pragma unroll
            for (int m = 0; m < 4; ++m) {
                const int row = u.pm * 256 + ai * 128 + wr * 64 + m * 16 + fr;
                const f32x4* sp = (const f32x4*)(ssc + (size_t)row * 8);
                const f32x4 q0 = sp[0], q1 = sp[1];
                const float t = ((q0[0] + q0[1]) + (q0[2] + q0[3])) + ((q1[0] + q1[1]) + (q1[2] + q1[3]));
                const float rs = __builtin_amdgcn_rsqf(t * (1.0f / 512.0f) + EPS);
                const int b_ = row >> 11, s_ = row & 2047;
                const size_t o = ((size_t)((b_ * 32 + h) * 2048 + s_)) * 128 + wc * 32 + 8 * fq;
                store8_bf16(KN + o, acc[ai][0][m][0] * rs, acc[ai][0][m][1] * rs);
                store8_bf16(V + o, acc[ai][1][m][0] * rs, acc[ai][1][m][1] * rs);
            }
    }
};

template <int MODE> __device__ __forceinline__ int src_col(int n) {
    if (MODE == 0) return n;
    if (MODE == 1) { if (n < 512) return n; const int o = n - 512; return 512 + (o >> 1) + 32 * (o & 1); }
    if (n < 4096) return (n >> 7) * 192 + (n & 127);
    const int r = n - 4096, h = r >> 6, o = r & 63; return h * 192 + 128 + (o >> 1) + 32 * (o & 1);
}
template <int MODE> __device__ __forceinline__ void transpose_item(const float* __restrict__ W, int K, int Nsrc, int Nout, const float* __restrict__ gain, bf16_t* WT, int row_off, LAS float* scr, int item, int lane) {
    const int nblk = Nout / 32, kb = item / nblk, nb = item % nblk, k0 = 64 * kb, n0 = 32 * nb;
    const int sc = src_col<MODE>(n0 + (lane & 31));
#pragma unroll 8
    for (int i = 0; i < 32; ++i) { const int kk = 2 * i + (lane >> 5); const float g = gain ? gain[k0 + kk] : 1.0f; scr[kk * 33 + (lane & 31)] = W[(size_t)(k0 + kk) * Nsrc + sc] * g; }
    asm volatile("s_waitcnt lgkmcnt(0)" ::: "memory");
    const int c = lane & 7;
#pragma unroll
    for (int j = 0; j < 4; ++j) { const int n = (lane >> 3) + 8 * j; const LAS float* s = scr + (8 * c) * 33 + n;
        u32x4 o; o.x = cvt_pk_bf16(s[0 * 33], s[1 * 33]); o.y = cvt_pk_bf16(s[2 * 33], s[3 * 33]); o.z = cvt_pk_bf16(s[4 * 33], s[5 * 33]); o.w = cvt_pk_bf16(s[6 * 33], s[7 * 33]);
        *(u32x4*)(WT + (size_t)(row_off + n0 + n) * K + k0 + 8 * c) = o; }
    asm volatile("s_waitcnt lgkmcnt(0)" ::: "memory");
}
__device__ __forceinline__ void phase0(const Params& p, LAS unsigned char* lds, int wave, int lane, int gw, int NGW) {
    LAS float* scr = (LAS float*)(lds + wave * 16384);
    bf16_t* W1T = (bf16_t*)(p.ws + WS_W1T); bf16_t* W2T = (bf16_t*)(p.ws + WS_W2T); bf16_t* W3T = (bf16_t*)(p.ws + WS_W3T);
    bf16_t* W4T = (bf16_t*)(p.ws + WS_W4T); bf16_t* W5T = (bf16_t*)(p.ws + WS_W5T); bf16_t* W6T = (bf16_t*)(p.ws + WS_W6T);
    constexpr int I1 = 32 * 384, I2 = 64 * 64, I3a = 32 * 152, I3b = 32 * 18, I4 = 12 * 192, I5 = 8 * 256, I6 = 64 * 64;
    constexpr int NIT = I1 + I2 + I3a + I3b + I4 + I5 + I6;
    for (int it = gw; it < NIT; it += NGW) {
        int r = it;
        if (r < I1) { transpose_item<0>(p.hg_w_in, 2048, 12288, 12288, p.norm_g, W1T, 0, scr, r, lane); continue; } r -= I1;
        if (r < I2) { transpose_item<0>(p.hg_w_out, 4096, 2048, 2048, nullptr, W2T, 0, scr, r, lane); continue; } r -= I2;
        if (r < I3a) { transpose_item<0>(p.mla_w_in, 2048, 4864, 4864, p.norm_g + 2048, W3T, 0, scr, r, lane); continue; } r -= I3a;
        if (r < I3b) { transpose_item<1>(p.w_kv_down, 2048, 576, 576, p.kv_in_norm_g, W3T, 4864, scr, r, lane); continue; } r -= I3b;
        if (r < I4) { transpose_item<2>(p.mla_w_q_up, 768, 6144, 6144, p.mla_q_norm_g, W4T, 0, scr, r, lane); continue; } r -= I4;
        if (r < I5) { transpose_item<0>(p.w_kv_up, 512, 8192, 8192, p.kv_norm_g, W5T, 0, scr, r, lane); continue; } r -= I5;
        transpose_item<0>(p.mla_w_out, 4096, 2048, 2048, nullptr, W6T, 0, scr, r, lane);
    }
    {
        u32x4* z = (u32x4*)(W3T + (size_t)5440 * 2048);
        for (int i = gw * 64 + lane; i < 192 * 2048 / 8; i += NGW * 64) z[i] = (u32x4){0u, 0u, 0u, 0u};
    }
    bf16_t* XN = (bf16_t*)(p.ws + WS_XN);
    for (int m = gw; m < NTOK; m += NGW) {
        const f32x4* xr = (const f32x4*)(p.x + (size_t)m * 2048) + lane;
        f32x4 v[8]; float s = 0.f;
#pragma unroll
        for (int j = 0; j < 8; ++j) { v[j] = xr[64 * j]; s += (v[j][0] * v[j][0] + v[j][1] * v[j][1]) + (v[j][2] * v[j][2] + v[j][3] * v[j][3]); }
        const float rs = __builtin_amdgcn_rsqf(wave_sum(s) * (1.0f / 2048.0f) + EPS);
        u32x2* o8 = (u32x2*)(XN + (size_t)m * 2048) + lane;
#pragma unroll
        for (int j = 0; j < 8; ++j) { u32x2 w; w.x = cvt_pk_bf16(v[j][0] * rs, v[j][1] * rs); w.y = cvt_pk_bf16(v[j][2] * rs, v[j][3] * rs); o8[64 * j] = w; }
    }
}

__device__ __forceinline__ void hgrn_naive(const Params& p, LAS unsigned char* lds, int tid) {
    if (blockIdx.x >= 64) return;
    const int bh = blockIdx.x, b = bh >> 4, h = bh & 15;
    LAS float* fg = (LAS float*)lds; LAS float* kks = fg + 128; LAS float* qs = kks + 128; LAS float* op = qs + 128; LAS float* red = op + 512;
    const float* F = p.out; const bf16_t* Qh = (const bf16_t*)(p.ws + WS_QH); const bf16_t* VI = (const bf16_t*)(p.ws + WS_VI); bf16_t* GS = (bf16_t*)(p.ws + WS_GS);
    const int v = tid & 255, half = tid >> 8, wave = tid >> 6, lane = tid & 63;
    float S[64];
#pragma unroll
    for (int j = 0; j < 64; ++j) S[j] = 0.f;
    float lb = 0.f;
    if (tid < 128) { const float a = p.hg_lb[h * 128 + tid], bb = p.hg_lb[2048 + h * 128 + tid]; lb = 1.0f / (1.0f + __expf(bb - a)); }
    const float gn = p.hg_g_norm[v];
    for (int t = 0; t < SEQ; ++t) {
        const size_t row = (size_t)b * SEQ + t;
        if (tid < 128) {
            const float f = F[row * 2048 + h * 128 + tid]; const float q = bf2f(Qh[row * 2048 + h * 128 + tid]);
            const float sg = 1.0f / (1.0f + __expf(-f));
            fg[tid] = lb + (1.0f - lb) * sg; kks[tid] = (1.0f - lb) * (1.0f - sg); qs[tid] = q;
        }
        const float iv = bf2f(VI[row * 4096 + h * 256 + v]);
        __syncthreads();
        float o = 0.f;
#pragma unroll
        for (int j = 0; j < 64; ++j) { const int k = half * 64 + j; S[j] = fg[k] * S[j] + kks[k] * iv; o += qs[k] * S[j]; }
        op[half * 256 + v] = o;
        __syncthreads();
        const float of = op[v] + op[256 + v];
        const float sq = wave_sum(of * of);
        if (lane == 0) red[wave] = sq;
        __syncthreads();
        const float tot = (red[0] + red[1]) + (red[2] + red[3]);
        const float rs = __builtin_amdgcn_rsqf(tot * (1.0f / 256.0f) + EPS);
        if (half == 0) { bf16_t* g = GS + row * 4096 + h * 256 + v; const float y = of * rs * gn * bf2f(*g); *g = (bf16_t)(cvt_pk_bf16(y, 0.f) & 0xffffu); }
    }
}

typedef short bf16x8 __attribute__((ext_vector_type(8)));
typedef short s16x4 __attribute__((ext_vector_type(4)));
typedef float f32x16 __attribute__((ext_vector_type(16)));
__device__ __forceinline__ s16x4 tr_read(LAS const unsigned char* p) { return __builtin_bit_cast(s16x4, __builtin_amdgcn_ds_read_tr16_b64_v4i16((LAS s16x4*)p)); }
__device__ __forceinline__ bf16_t f2bf(float x) { return (bf16_t)(cvt_pk_bf16(x, 0.f) & 0xffffu); }
#define HG_BAR() do { asm volatile("s_waitcnt vmcnt(0) lgkmcnt(0)" ::: "memory"); __builtin_amdgcn_s_barrier(); asm volatile("" ::: "memory"); } while (0)
#define HG_BAR_L() do { asm volatile("s_waitcnt lgkmcnt(0)" ::: "memory"); __builtin_amdgcn_s_barrier(); asm volatile("" ::: "memory"); } while (0)
__device__ __forceinline__ void hgrn_state_phase(const Params& p, LAS unsigned char* lds, int tid, int wave, int lane) {
    constexpr int SQT = 0, SDEC = 2048, SKD = 4096, SKDROW = 320, SVT = SKD + 64 * SKDROW, SVTROW = 192;
    const float* F = p.out; const bf16_t* VI = (const bf16_t*)(p.ws + WS_VI); bf16_t* ST = (bf16_t*)(p.ws + WS_ST);
    LAS float* QT = (LAS float*)(lds + SQT); LAS float* DEC = (LAS float*)(lds + SDEC);
    const int r32 = lane & 31, hi = lane >> 5, i16 = lane & 15, g1 = (lane >> 4) & 1;
    const int k = tid & 127, tq = tid >> 7;
    for (int unit = blockIdx.x; unit < 256; unit += gridDim.x) {
        const int bh = unit >> 2, vq = unit & 3, b = bh >> 4, h = bh & 15;
        float lb; { const float a = p.hg_lb[h * 128 + k], bb = p.hg_lb[2048 + h * 128 + k]; lb = 1.0f / (1.0f + __expf(bb - a)); }
        const float oml = 1.0f - lb;
        const float* Fp = F + ((size_t)(b * 2048 + 16 * tq)) * 2048 + h * 128 + k;
        const bf16_t* Vp = VI + ((size_t)(b * 2048 + (tid >> 3))) * 4096 + h * 256 + vq * 64 + (tid & 7) * 8;
        f32x16 acc;
#pragma unroll
        for (int r = 0; r < 16; ++r) acc[r] = 0.f;
        float fr[16]; u32x4 vr;
#pragma unroll
        for (int i = 0; i < 16; ++i) fr[i] = Fp[(size_t)i * 2048];
        vr = *(const u32x4*)Vp;
        const int vi = wave & 1, ki = wave >> 1;
        for (int c = 0; c < 32; ++c) {
            float cs[16], kk[16]; float run = 0.f;
#pragma unroll
            for (int i = 0; i < 16; ++i) {
                const float e = __builtin_amdgcn_exp2f(-1.4426950408889634f * fr[i]); const float sg = __builtin_amdgcn_rcpf(1.0f + e);
                run += __builtin_amdgcn_logf(lb + oml * sg); cs[i] = run; kk[i] = oml * e * sg;
            }
            QT[tq * 128 + k] = run;
            HG_BAR_L();
            const float q0 = QT[k], q1 = QT[128 + k], q2 = QT[256 + k], q3 = QT[384 + k];
            const float off = (tq > 0 ? q0 : 0.f) + (tq > 1 ? q1 : 0.f) + (tq > 2 ? q2 : 0.f), bl = (q0 + q1) + (q2 + q3);
#pragma unroll
            for (int i = 0; i < 16; ++i) *(LAS bf16_t*)(lds + SKD + (16 * tq + i) * SKDROW + k * 2) = f2bf(kk[i] * __builtin_amdgcn_exp2f(bl - (off + cs[i])));
            if (tq == 0) DEC[k] = __builtin_amdgcn_exp2f(bl);
            *(LAS u32x4*)(lds + SVT + (tid >> 3) * SVTROW + (tid & 7) * 16) = vr;
            if (c + 1 < 32) {
                const float* Fn = Fp + (size_t)(c + 1) * 64 * 2048;
#pragma unroll
                for (int i = 0; i < 16; ++i) fr[i] = Fn[(size_t)i * 2048];
                vr = *(const u32x4*)(Vp + (size_t)(c + 1) * 64 * 4096);
            }
            HG_BAR_L();
            {
                bf16_t* sp = ST + ((size_t)((bh * 32 + c) * 256 + vq * 64 + 32 * vi)) * 128 + 32 * ki + r32;
#pragma unroll
                for (int r = 0; r < 16; ++r) sp[(size_t)((r & 3) + 8 * (r >> 2) + 4 * hi) * 128] = f2bf(acc[r]);
                const float dc = DEC[32 * ki + r32];
#pragma unroll
                for (int r = 0; r < 16; ++r) acc[r] *= dc;
                LAS const unsigned char* va = lds + SVT + (8 * hi + (i16 >> 2)) * SVTROW + (32 * vi + 16 * g1 + 4 * (i16 & 3)) * 2;
                LAS const unsigned char* ka = lds + SKD + (8 * hi + (i16 >> 2)) * SKDROW + (32 * ki + 16 * g1 + 4 * (i16 & 3)) * 2;
#pragma unroll
                for (int st = 0; st < 4; ++st) {
                    const s16x4 a0 = tr_read(va + st * 16 * SVTROW), a1 = tr_read(va + st * 16 * SVTROW + 4 * SVTROW);
                    const s16x4 b0 = tr_read(ka + st * 16 * SKDROW), b1 = tr_read(ka + st * 16 * SKDROW + 4 * SKDROW);
                    const bf16x8 af = (bf16x8){a0[0], a0[1], a0[2], a0[3], a1[0], a1[1], a1[2], a1[3]};
                    const bf16x8 bf = (bf16x8){b0[0], b0[1], b0[2], b0[3], b1[0], b1[1], b1[2], b1[3]};
                    acc = __builtin_amdgcn_mfma_f32_32x32x16_bf16(af, bf, acc, 0, 0, 0);
                }
            }
        }
        HG_BAR_L();
    }
}
__device__ __forceinline__ void hgrn_out_phase(const Params& p, LAS unsigned char* lds, int tid, int wave, int lane) {
    constexpr int QROW = 272, OQD = 0, OQM = 17408, OKM = 34816, OQO = 52224, OKO = 60928, OVT = 69632, VROW = 576, OPS = 106496, PROW = 144, OQT = 115712, OROW = 1040;
    const float* F = p.out; const bf16_t* Qh = (const bf16_t*)(p.ws + WS_QH); const bf16_t* VI = (const bf16_t*)(p.ws + WS_VI); const bf16_t* ST = (const bf16_t*)(p.ws + WS_ST); bf16_t* GS = (bf16_t*)(p.ws + WS_GS);
    LAS float* QT = (LAS float*)(lds + OQT);
    const int r32 = lane & 31, hi = lane >> 5, i16 = lane & 15, g1 = (lane >> 4) & 1;
    const int k = tid & 127, tq = tid >> 7, th = tq >> 1;
    for (int unit = blockIdx.x; unit < 2048; unit += gridDim.x) {
        const int bh = unit >> 5, c = unit & 31, b = bh >> 4, h = bh & 15, row0 = b * 2048 + c * 64;
        float lb; { const float a = p.hg_lb[h * 128 + k], bb = p.hg_lb[2048 + h * 128 + k]; lb = 1.0f / (1.0f + __expf(bb - a)); }
        const float oml = 1.0f - lb;
        float fr[16]; bf16_t qv[16]; u32x4 vr[4]; bf16x8 sfr[8];
        { const float* Fp = F + ((size_t)(row0 + 16 * tq)) * 2048 + h * 128 + k; const bf16_t* Qp = Qh + ((size_t)(row0 + 16 * tq)) * 2048 + h * 128 + k;
#pragma unroll
          for (int i = 0; i < 16; ++i) { fr[i] = Fp[(size_t)i * 2048]; qv[i] = Qp[(size_t)i * 2048]; } }
#pragma unroll
        for (int j = 0; j < 4; ++j) { const int id = tid + 512 * j; vr[j] = *(const u32x4*)(VI + ((size_t)(row0 + (id >> 5))) * 4096 + h * 256 + (id & 31) * 8); }
        { const bf16_t* sp = ST + ((size_t)((bh * 32 + c) * 256 + 32 * wave + r32)) * 128 + 8 * hi;
#pragma unroll
          for (int s = 0; s < 8; ++s) sfr[s] = *(const bf16x8*)(sp + 16 * s); }
        float cs[16], kk[16]; float run = 0.f;
#pragma unroll
        for (int i = 0; i < 16; ++i) {
            const float e = __builtin_amdgcn_exp2f(-1.4426950408889634f * fr[i]); const float sg = __builtin_amdgcn_rcpf(1.0f + e);
            run += __builtin_amdgcn_logf(lb + oml * sg); cs[i] = run; kk[i] = oml * e * sg;
        }
        QT[tq * 128 + k] = run;
        HG_BAR_L();
        {
            const float q0 = QT[k], q1 = QT[128 + k], q2 = QT[256 + k];
            const float off = (tq > 0 ? q0 : 0.f) + (tq > 1 ? q1 : 0.f) + (tq > 2 ? q2 : 0.f), b31 = q0 + q1, bm = th ? (b31 + q2) : q0;
#pragma unroll
            for (int i = 0; i < 16; ++i) {
                const int t = 16 * tq + i; const float bc = off + cs[i], q = bf2f(qv[i]);
                *(LAS bf16_t*)(lds + OQD + t * QROW + k * 2) = f2bf(q * __builtin_amdgcn_exp2f(bc));
                *(LAS bf16_t*)(lds + OQM + t * QROW + k * 2) = f2bf(q * __builtin_amdgcn_exp2f(bc - bm));
                *(LAS bf16_t*)(lds + OKM + t * QROW + k * 2) = f2bf(kk[i] * __builtin_amdgcn_exp2f(bm - bc));
                if (th) *(LAS bf16_t*)(lds + OQO + (t - 32) * QROW + k * 2) = f2bf(q * __builtin_amdgcn_exp2f(bc - b31));
                else *(LAS bf16_t*)(lds + OKO + t * QROW + k * 2) = f2bf(kk[i] * __builtin_amdgcn_exp2f(b31 - bc));
            }
        }
#pragma unroll
        for (int j = 0; j < 4; ++j) { const int id = tid + 512 * j; *(LAS u32x4*)(lds + OVT + (id >> 5) * VROW + (id & 31) * 16) = vr[j]; }
        HG_BAR_L();
        if (wave < 3) {
            const int abase = (wave == 2 ? OQO : OQM) + (wave == 1 ? 32 * QROW : 0), bbase = (wave == 2 ? OKO : OKM) + (wave == 1 ? 32 * QROW : 0);
            LAS const unsigned char* ap = lds + abase + r32 * QROW + hi * 16; LAS const unsigned char* bp = lds + bbase + r32 * QROW + hi * 16;
            f32x16 pc;
#pragma unroll
            for (int r = 0; r < 16; ++r) pc[r] = 0.f;
#pragma unroll
            for (int s = 0; s < 8; ++s) pc = __builtin_amdgcn_mfma_f32_32x32x16_bf16(*(LAS const bf16x8*)(ap + 32 * s), *(LAS const bf16x8*)(bp + 32 * s), pc, 0, 0, 0);
            const int tb = (wave == 0 ? 0 : 32), sb = (wave == 1 ? 32 : 0);
#pragma unroll
            for (int r = 0; r < 16; ++r) { const int tl = (r & 3) + 8 * (r >> 2) + 4 * hi; float v = pc[r]; if (wave < 2 && r32 > tl) v = 0.f;
                *(LAS bf16_t*)(lds + OPS + (tb + tl) * PROW + (sb + r32) * 2) = f2bf(v); }
        }
        HG_BAR_L();
        f32x16 a0, a1;
#pragma unroll
        for (int r = 0; r < 16; ++r) { a0[r] = 0.f; a1[r] = 0.f; }
        {
            LAS const unsigned char* qp = lds + OQD + r32 * QROW + hi * 16;
#pragma unroll
            for (int s = 0; s < 8; ++s) {
                a0 = __builtin_amdgcn_mfma_f32_32x32x16_bf16(*(LAS const bf16x8*)(qp + 32 * s), sfr[s], a0, 0, 0, 0);
                a1 = __builtin_amdgcn_mfma_f32_32x32x16_bf16(*(LAS const bf16x8*)(qp + 32 * QROW + 32 * s), sfr[s], a1, 0, 0, 0);
            }
            LAS const unsigned char* vp = lds + OVT + (8 * hi + (i16 >> 2)) * VROW + (32 * wave + 16 * g1 + 4 * (i16 & 3)) * 2;
            LAS const unsigned char* pp = lds + OPS + r32 * PROW + hi * 16;
#pragma unroll
            for (int st = 0; st < 4; ++st) {
                const s16x4 v0 = tr_read(vp + st * 16 * VROW), v1 = tr_read(vp + st * 16 * VROW + 4 * VROW);
                const bf16x8 vf = (bf16x8){v0[0], v0[1], v0[2], v0[3], v1[0], v1[1], v1[2], v1[3]};
                if (st < 2) a0 = __builtin_amdgcn_mfma_f32_32x32x16_bf16(*(LAS const bf16x8*)(pp + 32 * st), vf, a0, 0, 0, 0);
                a1 = __builtin_amdgcn_mfma_f32_32x32x16_bf16(*(LAS const bf16x8*)(pp + 32 * PROW + 32 * st), vf, a1, 0, 0, 0);
            }
        }
        HG_BAR_L();
#pragma unroll
        for (int r = 0; r < 16; ++r) { const int tl = (r & 3) + 8 * (r >> 2) + 4 * hi;
            *(LAS float*)(lds + tl * OROW + (32 * wave + r32) * 4) = a0[r]; *(LAS float*)(lds + (32 + tl) * OROW + (32 * wave + r32) * 4) = a1[r]; }
        HG_BAR_L();
        {
            const int t = tid >> 3, seg = tid & 7;
            f32x4 ov[8]; float ssq = 0.f;
#pragma unroll
            for (int j = 0; j < 8; ++j) { ov[j] = *(LAS const f32x4*)(lds + t * OROW + seg * 128 + j * 16); ssq += (ov[j][0] * ov[j][0] + ov[j][1] * ov[j][1]) + (ov[j][2] * ov[j][2] + ov[j][3] * ov[j][3]); }
            ssq += __shfl_xor(ssq, 1); ssq += __shfl_xor(ssq, 2); ssq += __shfl_xor(ssq, 4);
            const float rs = __builtin_amdgcn_rsqf(ssq * (1.0f / 256.0f) + EPS);
            bf16_t* gp = GS + ((size_t)(row0 + t)) * 4096 + h * 256 + seg * 32; const f32x4* gn = (const f32x4*)(p.hg_g_norm + seg * 32);
#pragma unroll
            for (int j = 0; j < 4; ++j) {
                const u32x4 g = *(const u32x4*)(gp + 8 * j); const f32x4 n0 = gn[2 * j], n1 = gn[2 * j + 1]; const f32x4 x0 = ov[2 * j] * rs * n0, x1 = ov[2 * j + 1] * rs * n1;
                u32x4 w; w.x = cvt_pk_bf16(x0[0] * bflo(g.x), x0[1] * bfhi(g.x)); w.y = cvt_pk_bf16(x0[2] * bflo(g.y), x0[3] * bfhi(g.y));
                w.z = cvt_pk_bf16(x1[0] * bflo(g.z), x1[1] * bfhi(g.z)); w.w = cvt_pk_bf16(x1[2] * bflo(g.w), x1[3] * bfhi(g.w));
                *(u32x4*)(gp + 8 * j) = w;
            }
        }
    }
    HG_BAR_L();
}

__device__ __forceinline__ float dot2(unsigned a, unsigned b) { return bflo(a) * bflo(b) + bfhi(a) * bfhi(b); }
__device__ __forceinline__ void attn_naive(const Params& p, int gw, int NGW, int lane) {
    const bf16_t* Q = (const bf16_t*)(p.ws + WS_Q); const bf16_t* KN = (const bf16_t*)(p.ws + WS_KN); const bf16_t* KR = (const bf16_t*)(p.ws + WS_KR);
    const bf16_t* V = (const bf16_t*)(p.ws + WS_V); bf16_t* GATE = (bf16_t*)(p.ws + WS_GATE);
    for (int unit = gw; unit < 16384; unit += NGW) {
        const int quar = unit & 3, qblk = (unit >> 2) & 31, bh = unit >> 7, b = bh >> 5, h = bh & 31;
        const int qi = qblk * 64 + lane;
        unsigned qr[96];
        { const u32x4* qp = (const u32x4*)(Q + ((size_t)(bh * 2048 + qi)) * 192);
#pragma unroll
          for (int i = 0; i < 24; ++i) { const u32x4 t = qp[i]; qr[4 * i] = t.x; qr[4 * i + 1] = t.y; qr[4 * i + 2] = t.z; qr[4 * i + 3] = t.w; } }
        float o[32];
#pragma unroll
        for (int d = 0; d < 32; ++d) o[d] = 0.f;
        float mx = -1e30f, l = 0.f;
        const int jmax = qblk * 64 + 63;
        for (int j = 0; j <= jmax; ++j) {
            const u32x4* kp = (const u32x4*)(KN + ((size_t)(bh * 2048 + j)) * 128);
            const u32x4* rp = (const u32x4*)(KR + ((size_t)(b * 2048 + j)) * 64);
            float s = 0.f;
#pragma unroll
            for (int i = 0; i < 96; ++i) asm volatile("" : "+v"(qr[i]));
#pragma unroll
            for (int i = 0; i < 16; ++i) { const u32x4 kv = kp[i]; s += dot2(qr[4 * i], kv.x) + dot2(qr[4 * i + 1], kv.y) + dot2(qr[4 * i + 2], kv.z) + dot2(qr[4 * i + 3], kv.w); if ((i & 3) == 3) asm volatile("" ::: "memory"); }
#pragma unroll
            for (int i = 0; i < 8; ++i) { const u32x4 kv = rp[i]; s += dot2(qr[64 + 4 * i], kv.x) + dot2(qr[64 + 4 * i + 1], kv.y) + dot2(qr[64 + 4 * i + 2], kv.z) + dot2(qr[64 + 4 * i + 3], kv.w); if ((i & 3) == 3) asm volatile("" ::: "memory"); }
            if (j <= qi) {
                if (s > mx) { const float al = __builtin_amdgcn_exp2f(mx - s); l *= al;
#pragma unroll
                    for (int d = 0; d < 32; ++d) o[d] *= al;
                    mx = s; }
                const float pe = __builtin_amdgcn_exp2f(s - mx); l += pe;
                const u32x4* vp = (const u32x4*)(V + ((size_t)(bh * 2048 + j)) * 128 + quar * 32);
#pragma unroll
                for (int i = 0; i < 4; ++i) { const u32x4 vv = vp[i];
                    o[8 * i] += pe * bflo(vv.x); o[8 * i + 1] += pe * bfhi(vv.x); o[8 * i + 2] += pe * bflo(vv.y); o[8 * i + 3] += pe * bfhi(vv.y);
                    o[8 * i + 4] += pe * bflo(vv.z); o[8 * i + 5] += pe * bfhi(vv.z); o[8 * i + 6] += pe * bflo(vv.w); o[8 * i + 7] += pe * bfhi(vv.w); }
            }
        }
        const float il = 1.0f / l;
        u32x4* gp = (u32x4*)(GATE + ((size_t)(b * 2048 + qi)) * 4096 + h * 128 + quar * 32);
#pragma unroll
        for (int i = 0; i < 4; ++i) { const u32x4 g = gp[i]; u32x4 w;
            w.x = cvt_pk_bf16(o[8 * i] * il * bflo(g.x), o[8 * i + 1] * il * bfhi(g.x)); w.y = cvt_pk_bf16(o[8 * i + 2] * il * bflo(g.y), o[8 * i + 3] * il * bfhi(g.y));
            w.z = cvt_pk_bf16(o[8 * i + 4] * il * bflo(g.z), o[8 * i + 5] * il * bfhi(g.z)); w.w = cvt_pk_bf16(o[8 * i + 6] * il * bflo(g.w), o[8 * i + 7] * il * bfhi(g.w));
            gp[i] = w; }
    }
}

constexpr int AT_KROW = 400, AT_VROW = 320, AT_KB = 64 * AT_KROW, AT_VB = 64 * AT_VROW, AT_STAGE = AT_KB + AT_VB, AT_WSF = 2 * AT_STAGE;
__device__ __forceinline__ void attn_unit(int bh, int qb, const bf16_t* __restrict__ Q, const bf16_t* __restrict__ KN, const bf16_t* __restrict__ KR, const bf16_t* __restrict__ V, bf16_t* GATE,
                                          LAS unsigned char* lds, int tid, int wave, int lane) {
    const int r32 = lane & 31, hi = lane >> 5, b = bh >> 5, h = bh & 31;
    const int q0 = qb * 256, NT = 4 * (qb + 1);
    LAS float* wsf = (LAS float*)(lds + AT_WSF) + wave * 32;
    const int krow = tid >> 4, kc = tid & 15, rrow = tid >> 3, rc = tid & 7;
    const bf16_t* kn_src = KN + ((size_t)(bh * 2048 + krow)) * 128 + kc * 8;
    const bf16_t* kr_src = KR + ((size_t)(b * 2048 + rrow)) * 64 + rc * 8;
    const bf16_t* v_src = V + ((size_t)(bh * 2048 + krow)) * 128 + kc * 8;
    const int kn_dst = krow * AT_KROW + kc * 16, kr_dst = rrow * AT_KROW + 256 + rc * 16, v_dst = AT_KB + krow * AT_VROW + kc * 16;
    u32x4 sk0, sk1, skr, sv0, sv1;
#define AT_LOAD(t) do { const size_t o_ = (size_t)(t) * 64 * 128; sk0 = *(const u32x4*)(kn_src + o_); sk1 = *(const u32x4*)(kn_src + o_ + 32 * 128); skr = *(const u32x4*)(kr_src + (size_t)(t) * 64 * 64); \
        sv0 = *(const u32x4*)(v_src + o_); sv1 = *(const u32x4*)(v_src + o_ + 32 * 128); } while (0)
#define AT_WRITE(bufoff) do { LAS unsigned char* d_ = lds + (bufoff); *(LAS u32x4*)(d_ + kn_dst) = sk0; *(LAS u32x4*)(d_ + kn_dst + 32 * AT_KROW) = sk1; *(LAS u32x4*)(d_ + kr_dst) = skr; \
        *(LAS u32x4*)(d_ + v_dst) = sv0; *(LAS u32x4*)(d_ + v_dst + 32 * AT_VROW) = sv1; } while (0)
    AT_LOAD(0);
    bf16x8 qf[12];
    { const bf16_t* qrow = Q + ((size_t)(bh * 2048 + q0 + wave * 32 + r32)) * 192 + hi * 8;
#pragma unroll
      for (int k = 0; k < 12; ++k) qf[k] = *(const bf16x8*)(qrow + 16 * k); }
    f32x16 o[4];
#pragma unroll
    for (int d = 0; d < 4; ++d)
#pragma unroll
        for (int r = 0; r < 16; ++r) o[d][r] = 0.f;
    float mrun = -1e30f, lrun = 0.f;
    AT_WRITE(0);
    if (NT > 1) AT_LOAD(1);
    asm volatile("s_waitcnt lgkmcnt(0)" ::: "memory"); __builtin_amdgcn_s_barrier(); asm volatile("" ::: "memory");
    const int ka_off = r32 * AT_KROW + hi * 16;
    const int i16 = lane & 15, g1 = (lane >> 4) & 1;
    const int va_off = AT_KB + (4 * hi + (i16 >> 2)) * AT_VROW + (16 * g1 + 4 * (i16 & 3)) * 2;
    const int qloc = 32 * wave + r32;
    for (int t = 0; t < NT; ++t) {
        const int cur = (t & 1) * AT_STAGE;
        const int kvrel = 64 * t - q0;
        if (kvrel <= 32 * wave + 31) {
            LAS const unsigned char* kp = lds + cur + ka_off;
            f32x16 p0, p1;
#pragma unroll
            for (int r = 0; r < 16; ++r) { p0[r] = 0.f; p1[r] = 0.f; }
#pragma unroll
            for (int k = 0; k < 12; ++k) {
                const bf16x8 a0 = *(LAS const bf16x8*)(kp + k * 32), a1 = *(LAS const bf16x8*)(kp + 32 * AT_KROW + k * 32);
                p0 = __builtin_amdgcn_mfma_f32_32x32x16_bf16(a0, qf[k], p0, 0, 0, 0);
                p1 = __builtin_amdgcn_mfma_f32_32x32x16_bf16(a1, qf[k], p1, 0, 0, 0);
                if ((k % 3) == 2) asm volatile("" ::: "memory");
            }
            if (kvrel + 63 > 32 * wave) {
#pragma unroll
                for (int r = 0; r < 16; ++r) { const int kv = kvrel + (r & 3) + 8 * (r >> 2) + 4 * hi;
                    if (kv > qloc) p0[r] = -INFINITY; if (kv + 32 > qloc) p1[r] = -INFINITY; }
            }
            float rm = fmaxf(p0[0], p1[0]);
#pragma unroll
            for (int r = 1; r < 16; ++r) rm = fmaxf(rm, fmaxf(p0[r], p1[r]));
            rm = fmaxf(rm, __shfl_xor(rm, 32));
            if (__any(rm > mrun + 8.0f)) {
                const float mn = fmaxf(mrun, rm), al = __builtin_amdgcn_exp2f(mrun - mn);
                mrun = mn; lrun *= al;
                if (hi == 0) wsf[r32] = al;
                asm volatile("s_waitcnt lgkmcnt(0)" ::: "memory");
#pragma unroll
                for (int g = 0; g < 4; ++g) { const f32x4 a4 = *(LAS const f32x4*)(wsf + 8 * g + 4 * hi);
#pragma unroll
                    for (int d = 0; d < 4; ++d) { o[d][4 * g] *= a4[0]; o[d][4 * g + 1] *= a4[1]; o[d][4 * g + 2] *= a4[2]; o[d][4 * g + 3] *= a4[3]; } }
            }
            float ls = 0.f;
#pragma unroll
            for (int r = 0; r < 16; ++r) { p0[r] = __builtin_amdgcn_exp2f(p0[r] - mrun); p1[r] = __builtin_amdgcn_exp2f(p1[r] - mrun); ls += p0[r] + p1[r]; }
            lrun += ls;
            bf16x8 pa[4];
#pragma unroll
            for (int s2 = 0; s2 < 2; ++s2) {
                u32x4 w0, w1;
                w0.x = cvt_pk_bf16(p0[8 * s2], p0[8 * s2 + 1]); w0.y = cvt_pk_bf16(p0[8 * s2 + 2], p0[8 * s2 + 3]); w0.z = cvt_pk_bf16(p0[8 * s2 + 4], p0[8 * s2 + 5]); w0.w = cvt_pk_bf16(p0[8 * s2 + 6], p0[8 * s2 + 7]);
                w1.x = cvt_pk_bf16(p1[8 * s2], p1[8 * s2 + 1]); w1.y = cvt_pk_bf16(p1[8 * s2 + 2], p1[8 * s2 + 3]); w1.z = cvt_pk_bf16(p1[8 * s2 + 4], p1[8 * s2 + 5]); w1.w = cvt_pk_bf16(p1[8 * s2 + 6], p1[8 * s2 + 7]);
                pa[s2] = __builtin_bit_cast(bf16x8, w0); pa[2 + s2] = __builtin_bit_cast(bf16x8, w1);
            }
            LAS const unsigned char* vp = lds + cur + va_off;
#pragma unroll
            for (int s = 0; s < 4; ++s) {
                const int rb = (16 * (s & 1) + 32 * (s >> 1)) * AT_VROW;
#pragma unroll
                for (int d = 0; d < 4; ++d) {
                    const s16x4 lo = tr_read(vp + rb + d * 64), hh = tr_read(vp + rb + 8 * AT_VROW + d * 64);
                    const bf16x8 vf = (bf16x8){lo[0], lo[1], lo[2], lo[3], hh[0], hh[1], hh[2], hh[3]};
                    o[d] = __builtin_amdgcn_mfma_f32_32x32x16_bf16(pa[s], vf, o[d], 0, 0, 0);
                }
                asm volatile("" ::: "memory");
            }
        }
        if (t + 1 < NT) AT_WRITE(((t + 1) & 1) * AT_STAGE);
        asm volatile("s_waitcnt lgkmcnt(0)" ::: "memory"); __builtin_amdgcn_s_barrier(); asm volatile("" ::: "memory");
        if (t + 2 < NT) AT_LOAD(t + 2);
    }
    lrun += __shfl_xor(lrun, 32);
    if (hi == 0) wsf[r32] = 1.0f / lrun;
    asm volatile("s_waitcnt lgkmcnt(0)" ::: "memory");
#pragma unroll
    for (int g = 0; g < 4; ++g) {
        const f32x4 li = *(LAS const f32x4*)(wsf + 8 * g + 4 * hi);
#pragma unroll
        for (int i = 0; i < 4; ++i) {
            const int row = q0 + 32 * wave + 8 * g + 4 * hi + i;
            bf16_t* gp = GATE + ((size_t)(b * 2048 + row)) * 4096 + h * 128 + r32;
#pragma unroll
            for (int d = 0; d < 4; ++d) { const float y = o[d][4 * g + i] * li[i] * bf2f(gp[32 * d]); gp[32 * d] = (bf16_t)(cvt_pk_bf16(y, 0.f) & 0xffffu); }
        }
    }
#undef AT_LOAD
#undef AT_WRITE
}
__device__ __forceinline__ void attn_phase(const Params& p, LAS unsigned char* lds, int tid, int wave, int lane) {
    const bf16_t* Q = (const bf16_t*)(p.ws + WS_Q); const bf16_t* KN = (const bf16_t*)(p.ws + WS_KN); const bf16_t* KR = (const bf16_t*)(p.ws + WS_KR);
    const bf16_t* V = (const bf16_t*)(p.ws + WS_V); bf16_t* GATE = (bf16_t*)(p.ws + WS_GATE);
    for (int pi = blockIdx.x; pi < 512; pi += gridDim.x) {
        const int bh = pi >> 2, pp = pi & 3;
        attn_unit(bh, 7 - pp, Q, KN, KR, V, GATE, lds, tid, wave, lane);
        attn_unit(bh, pp, Q, KN, KR, V, GATE, lds, tid, wave, lane);
    }
}

__device__ __forceinline__ void final_norm(const Params& p, int gw, int NGW, int lane) {
    const float* ss2 = (const float*)(p.ws + WS_SS2);
    for (int m = gw; m < NTOK; m += NGW) {
        const float t = wave_sum(lane < 32 ? ss2[(size_t)m * 32 + lane] : 0.f);
        const float rs = __builtin_amdgcn_rsqf(t * (1.0f / 2048.0f) + EPS);
        f32x4* xr = (f32x4*)(p.out + (size_t)m * 2048) + lane; const f32x4* gr = (const f32x4*)p.final_norm_g + lane;
#pragma unroll
        for (int j = 0; j < 8; ++j) { const f32x4 v = xr[64 * j], g = gr[64 * j]; xr[64 * j] = v * rs * g; }
    }
}

__global__ void __launch_bounds__(512) yoco_fwd(Params p) {
    extern __shared__ __attribute__((aligned(16))) unsigned char lds_raw[];
    LAS unsigned char* lds = (LAS unsigned char*)lds_raw;
    cg::grid_group grid = cg::this_grid();
    const int wave = __builtin_amdgcn_readfirstlane(threadIdx.x >> 6);
    const int G = gridDim.x, gw = blockIdx.x * 8 + wave, NGW = G * 8;
    unsigned char* ws = p.ws;
    phase0(p, lds, wave, pg8::pg8_lane_id(), gw, NGW);
    grid.sync();
    { pg8::Gemm g{(const bf16_t*)(ws + WS_XN), (const bf16_t*)(ws + WS_W1T), NTOK, 12288, 2048}; pg8::StaticOrder S; S.init(NTOK, 12288, G, (int)blockIdx.x);
      EpiG1 E{(bf16_t*)(ws + WS_QH), p.out, (bf16_t*)(ws + WS_VI), (bf16_t*)(ws + WS_GS)};
      pg8::gemm_phase<EpiG1, pg8::StaticOrder, PG8_ALIGN, PG8_SP2>(lds, g, S, E, wave); }
    grid.sync();
    { const int l_ = pg8::pg8_lane_id(); hgrn_state_phase(p, lds, wave * 64 + l_, wave, l_); }
    grid.sync();
    { const int l_ = pg8::pg8_lane_id(); hgrn_out_phase(p, lds, wave * 64 + l_, wave, l_); }
    grid.sync();
    { pg8::Gemm g{(const bf16_t*)(ws + WS_GS), (const bf16_t*)(ws + WS_W2T), NTOK, 2048, 4096}; pg8::StaticOrder S; S.init(NTOK, 2048, G, (int)blockIdx.x);
      EpiRes<true> E{p.x, p.out, (bf16_t*)(ws + WS_H1B), (float*)(ws + WS_SS1)};
      pg8::gemm_phase<EpiRes<true>, pg8::StaticOrder, PG8_ALIGN, PG8_SP2>(lds, g, S, E, wave); }
    grid.sync();
    { pg8::Gemm g{(const bf16_t*)(ws + WS_H1B), (const bf16_t*)(ws + WS_W3T), NTOK, 5632, 2048}; pg8::StaticOrder S; S.init(NTOK, 5632, G, (int)blockIdx.x);
      EpiG3 E{(const float*)(ws + WS_SS1), (bf16_t*)(ws + WS_CQ), (bf16_t*)(ws + WS_GATE), (bf16_t*)(ws + WS_C), (bf16_t*)(ws + WS_KR), (float*)(ws + WS_SSQ), (float*)(ws + WS_SSC)};
      pg8::gemm_phase<EpiG3, pg8::StaticOrder, PG8_ALIGN, PG8_SP2>(lds, g, S, E, wave); }
    grid.sync();
    { pg8::Gemm g{(const bf16_t*)(ws + WS_CQ), (const bf16_t*)(ws + WS_W4T), NTOK, 6144, 768}; pg8::StaticOrder S; S.init(NTOK, 6144, G, (int)blockIdx.x);
      EpiQ E{(const float*)(ws + WS_SSQ), (bf16_t*)(ws + WS_Q)};
      pg8::gemm_phase<EpiQ, pg8::StaticOrder, PG8_ALIGN, PG8_SP2>(lds, g, S, E, wave); }
    { pg8::Gemm g{(const bf16_t*)(ws + WS_C), (const bf16_t*)(ws + WS_W5T), NTOK, 8192, 512}; pg8::StaticOrder S; S.init(NTOK, 8192, G, (int)blockIdx.x);
      EpiKV E{(const float*)(ws + WS_SSC), (bf16_t*)(ws + WS_KN), (bf16_t*)(ws + WS_V)};
      pg8::gemm_phase<EpiKV, pg8::StaticOrder, PG8_ALIGN, PG8_SP2>(lds, g, S, E, wave); }
    grid.sync();
    { const int l_ = pg8::pg8_lane_id(); attn_phase(p, lds, wave * 64 + l_, wave, l_); }
    grid.sync();
    { pg8::Gemm g{(const bf16_t*)(ws + WS_GATE), (const bf16_t*)(ws + WS_W6T), NTOK, 2048, 4096}; pg8::StaticOrder S; S.init(NTOK, 2048, G, (int)blockIdx.x);
      EpiRes<false> E{p.out, p.out, nullptr, (float*)(ws + WS_SS2)};
      pg8::gemm_phase<EpiRes<false>, pg8::StaticOrder, PG8_ALIGN, PG8_SP2>(lds, g, S, E, wave); }
    grid.sync();
    final_norm(p, gw, NGW, pg8::pg8_lane_id());
}

extern "C" void kernel_launch(void* const* d_in, const int* in_sizes, int n_in, void* d_out, int out_size, void* d_ws, size_t ws_size, hipStream_t stream) {
    static int grid = 0;
    if (grid == 0) {
        if (n_in != 15 || out_size != NTOK * DM || ws_size < WS_NEED) { fprintf(stderr, "kernel_launch: unexpected shapes (n_in %d out %d ws %zu)\n", n_in, out_size, ws_size); grid = -1; return; }
        int dev = 0, cus = 0, per_cu = 0;
        hipGetDevice(&dev); hipDeviceGetAttribute(&cus, hipDeviceAttributeMultiprocessorCount, dev);
        hipFuncSetAttribute((const void*)yoco_fwd, hipFuncAttributeMaxDynamicSharedMemorySize, LDS_BYTES);
        hipOccupancyMaxActiveBlocksPerMultiprocessor(&per_cu, (const void*)yoco_fwd, 512, LDS_BYTES);
        if (per_cu < 1) per_cu = 1;
        (void)hipGetLastError();
        grid = cus * per_cu;
    }
    if (grid < 0) return;
    Params p{};
    p.x = (const float*)d_in[0]; p.norm_g = (const float*)d_in[1]; p.hg_w_in = (const float*)d_in[2]; p.hg_g_norm = (const float*)d_in[3]; p.hg_w_out = (const float*)d_in[4];
    p.hg_lb = (const float*)d_in[5]; p.kv_in_norm_g = (const float*)d_in[6]; p.w_kv_down = (const float*)d_in[7]; p.kv_norm_g = (const float*)d_in[8]; p.w_kv_up = (const float*)d_in[9];
    p.mla_w_in = (const float*)d_in[10]; p.mla_q_norm_g = (const float*)d_in[11]; p.mla_w_q_up = (const float*)d_in[12]; p.mla_w_out = (const float*)d_in[13]; p.final_norm_g = (const float*)d_in[14];
    p.out = (float*)d_out; p.ws = (unsigned char*)d_ws;
    void* args[] = {&p};
    hipError_t e = hipLaunchCooperativeKernel((const void*)yoco_fwd, dim3(grid), dim3(512), args, LDS_BYTES, stream);
    if (e != hipSuccess) fprintf(stderr, "cooperative launch failed: %s (grid %d)\n", hipGetErrorString(e), grid);
}
```

```cpp
#include <hip/hip_runtime.h>
#include <hip/hip_cooperative_groups.h>
#include <cstdio>
#include <cstdint>
namespace cg = cooperative_groups;
namespace pg8 {
#define PG8_LAS __attribute__((address_space(3)))
typedef unsigned short bf16_t;
typedef short bf16x8 __attribute__((ext_vector_type(8)));
typedef float f32x4 __attribute__((ext_vector_type(4)));
typedef unsigned u32x4 __attribute__((ext_vector_type(4)));
constexpr int BM = 256, BK = 64, HALF = 128, HTB = HALF * BK * 2  , STAGE_BYTES = 8 * HTB, NXCD = 8, WGM = 8;

__host__ __device__ __forceinline__ int lds_byte(int r, int c) { const int st = (r >> 4) * 2 + (c >> 5), rr = r & 15, cc = c & 31, ob = rr * 64 + cc * 2; return st * 1024 + (ob ^ (((ob >> 9) & 1) << 5)); }
__host__ __device__ __forceinline__ void stage_rc(int b, int& R, int& C) { const int st = b / 1024, sb = b % 1024, swz = sb ^ (((sb >> 9) & 1) << 5); R = (st >> 1) * 16 + swz / 64; C = (st & 1) * 32 + (swz % 64) / 2; }
__host__ __device__ __forceinline__ int perm32(int rho) { const int n = rho >> 4, i = rho & 15; return 8 * (i >> 2) + 4 * n + (i & 3); }

struct Unit { int pm, pn; };
struct Gemm { const bf16_t* A; const bf16_t* Bt; int M, N, K; };

struct StaticOrder {
    int nM, nN, nwg, G, c;
    __host__ __device__ void init(int M, int N, int G_, int c_) { nM = M / BM; nN = N / BM; nwg = nM * nN; G = G_; c = c_; }
    __host__ __device__ bool next(int i, Unit& u) const {
        const long L = (long)i * G + c; if (L >= nwg) return false;
        int wgid = (int)L; { const int q = nwg / NXCD, r = nwg % NXCD, xcd = wgid % NXCD, off = wgid / NXCD; wgid = (xcd < r ? xcd * (q + 1) : r * (q + 1) + (xcd - r) * q) + off; }
        const int nig = WGM * nN, gid = wgid / nig, fm = gid * WGM, gsz = (nM - fm) < WGM ? (nM - fm) : WGM;
        u.pm = fm + ((wgid % nig) % gsz); u.pn = (wgid % nig) / gsz; return true;
    }
    __device__ __forceinline__ void a_ready(const Unit&) const {}
    __device__ __forceinline__ void done(const Unit&) const {}
};

__device__ __forceinline__ unsigned cvt_pk_bf16(float lo, float hi) { unsigned r; asm volatile("v_cvt_pk_bf16_f32 %0, %1, %2" : "=v"(r) : "v"(lo), "v"(hi)); return r; }
__device__ __forceinline__ int pg8_lane_id() { int l; asm volatile("v_mbcnt_lo_u32_b32 %0, -1, 0\n\tv_mbcnt_hi_u32_b32 %0, -1, %0" : "=v"(l)); return l; }
template <class Epi, class Sched, bool ALIGN_EPI = false, bool SP2 = false>
__device__ __forceinline__ void gemm_phase(PG8_LAS unsigned char* lds, const Gemm g, const Sched& S, const Epi& E, int wave_id) {
    const int wid = wave_id, lane = pg8_lane_id(), tid = wid * 64 + lane, wr = wid >> 2, wc = wid & 3, fr = lane & 15, fq = lane >> 4;
    const int K = g.K, nt = K / BK;
    unsigned voffA[2], voffB[2];
#pragma unroll
    for (int i = 0; i < 2; ++i) { int R, C; stage_rc(tid * 16 + i * 8192, R, C); const int Rb = Epi::PERM ? ((R & ~31) + perm32(R & 31)) : R;
        voffA[i] = (unsigned)(R * K + C) * 2u; voffB[i] = (unsigned)(Rb * K + C) * 2u; }
    const size_t kstep = (size_t)(BK * 2);
    const size_t hstep = (size_t)HALF * K * 2;
    const size_t tstep = 2 * hstep;
    const unsigned ldsw = (unsigned)wid * 1024u;
    const int aoff = lds_byte(wr * 64 + fr, fq * 8), boff = lds_byte(wc * 32 + fr, fq * 8);
#define PG8_SA(b, h) (((b) * 2 + (h)) * HTB)
#define PG8_SB(b, h) ((4 + (b) * 2 + (h)) * HTB)
#define PG8_STAGE(bufoff, gbase, voff) do { _Pragma("unroll") for (int _i = 0; _i < 2; ++_i) \
        __builtin_amdgcn_global_load_lds((const unsigned*)((const char*)(gbase) + (voff)[_i]), (PG8_LAS unsigned*)(lds + (bufoff) + ldsw + _i * 8192), 16, 0, 0); } while (0)
#define PG8_LDA(dst, b, h) do { _Pragma("unroll") for (int m = 0; m < 4; ++m) _Pragma("unroll") for (int k = 0; k < 2; ++k) dst[m][k] = *(const PG8_LAS bf16x8*)(lds + PG8_SA(b, h) + aoff + m * 2048 + k * 1024); } while (0)
#define PG8_LDB(dst, b, h) do { _Pragma("unroll") for (int n = 0; n < 2; ++n) _Pragma("unroll") for (int k = 0; k < 2; ++k) dst[n][k] = *(const PG8_LAS bf16x8*)(lds + PG8_SB(b, h) + boff + n * 2048 + k * 1024); } while (0)
#define PG8_MMA(ai, bj, At, Bt) do { __builtin_amdgcn_s_setprio(1); _Pragma("unroll") for (int m = 0; m < 4; ++m) _Pragma("unroll") for (int n = 0; n < 2; ++n) _Pragma("unroll") for (int k = 0; k < 2; ++k) \
        acc[ai][bj][m][n] = __builtin_amdgcn_mfma_f32_16x16x32_bf16(Bt[n][k], At[m][k], acc[ai][bj][m][n], 0, 0, 0); __builtin_amdgcn_s_setprio(0); } while (0)
#define PG8_WAIT_V(n) asm volatile("s_waitcnt vmcnt(" #n ")" ::: "memory")
#define PG8_WAIT_L(n) asm volatile("s_waitcnt lgkmcnt(" #n ")" ::: "memory")
#define PG8_BAR __builtin_amdgcn_s_barrier()
#define PG8_SCHED __builtin_amdgcn_sched_barrier(0)
    Unit cur, nxt; int ui = 0;
    if (!S.next(0, cur)) return;
    f32x4 acc[2][2][4][2];
#pragma unroll
    for (int a = 0; a < 2; ++a)
#pragma unroll
        for (int b = 0; b < 2; ++b)
#pragma unroll
            for (int m = 0; m < 4; ++m)
#pragma unroll
                for (int n = 0; n < 2; ++n) acc[a][b][m][n] = (f32x4){0.f, 0.f, 0.f, 0.f};
    bf16x8 At[4][2], B0[2][2], B1[2][2];
    const char* cA = (const char*)g.A + (size_t)cur.pm * tstep; const char* cB = (const char*)g.Bt + (size_t)cur.pn * tstep;
    S.a_ready(cur);
    if constexpr (SP2) {
        PG8_STAGE(PG8_SB(0, 0), cB, voffB); PG8_STAGE(PG8_SB(0, 1), cB + hstep, voffB); PG8_STAGE(PG8_SA(0, 0), cA, voffA); PG8_STAGE(PG8_SA(0, 1), cA + hstep, voffA);
        if (wr == 1) PG8_BAR;
        PG8_WAIT_V(2); PG8_BAR;
        PG8_STAGE(PG8_SB(1, 0), cB + kstep, voffB); PG8_STAGE(PG8_SA(1, 0), cA + kstep, voffA); PG8_STAGE(PG8_SB(1, 1), cB + hstep + kstep, voffB);
        PG8_WAIT_V(6); PG8_BAR;
    } else {
        PG8_STAGE(PG8_SB(0, 0), cB, voffB); PG8_STAGE(PG8_SA(0, 0), cA, voffA); PG8_STAGE(PG8_SB(0, 1), cB + hstep, voffB); PG8_STAGE(PG8_SA(0, 1), cA + hstep, voffA);
        if (wr == 1) PG8_BAR;
        PG8_WAIT_V(4); PG8_BAR;
        PG8_STAGE(PG8_SB(1, 0), cB + kstep, voffB); PG8_STAGE(PG8_SA(1, 0), cA + kstep, voffA); PG8_STAGE(PG8_SB(1, 1), cB + hstep + kstep, voffB);
        PG8_WAIT_V(6); PG8_BAR;
    }
    for (;;) {
        const bool has_next = S.next(ui + 1, nxt);
        const char* nA = has_next ? (const char*)g.A + (size_t)nxt.pm * tstep : cA; const char* nB = has_next ? (const char*)g.Bt + (size_t)nxt.pn * tstep : cB;
        for (int t = 0; t < nt; t += 2) {
            const bool last = (t == nt - 2);
            const char* a1 = cA + (size_t)(t + 1) * kstep;
            const char* a2 = last ? nA : cA + (size_t)(t + 2) * kstep; const char* b2 = last ? nB : cB + (size_t)(t + 2) * kstep;
            const char* a3 = a2 + kstep; const char* b3 = b2 + kstep;
            if (last && has_next) S.a_ready(nxt);
            if constexpr (SP2) {
            PG8_LDB(B0, 0, 0); PG8_LDB(B1, 0, 1); PG8_SCHED; PG8_LDA(At, 0, 0); PG8_STAGE(PG8_SA(1, 1), a1 + hstep, voffA);
            PG8_WAIT_V(8); PG8_WAIT_L(0); PG8_BAR; PG8_MMA(0, 0, At, B0); PG8_MMA(0, 1, At, B1); PG8_BAR; PG8_SCHED;
            PG8_LDA(At, 0, 1); PG8_STAGE(PG8_SB(0, 0), b2, voffB); PG8_STAGE(PG8_SB(0, 1), b2 + hstep, voffB); PG8_STAGE(PG8_SA(0, 0), a2, voffA);
            PG8_WAIT_V(8); PG8_WAIT_L(0); PG8_BAR; PG8_MMA(1, 0, At, B0); PG8_MMA(1, 1, At, B1); PG8_BAR; PG8_SCHED;
            PG8_LDB(B0, 1, 0); PG8_LDB(B1, 1, 1); PG8_SCHED; PG8_LDA(At, 1, 0); PG8_STAGE(PG8_SA(0, 1), a2 + hstep, voffA);
            PG8_WAIT_V(8); PG8_WAIT_L(0); PG8_BAR; PG8_MMA(0, 0, At, B0); PG8_MMA(0, 1, At, B1); PG8_BAR; PG8_SCHED;
            PG8_LDA(At, 1, 1); PG8_STAGE(PG8_SB(1, 0), b3, voffB); PG8_STAGE(PG8_SB(1, 1), b3 + hstep, voffB); PG8_STAGE(PG8_SA(1, 0), a3, voffA);
            PG8_WAIT_V(8); PG8_WAIT_L(0); PG8_BAR; PG8_MMA(1, 0, At, B0); PG8_MMA(1, 1, At, B1); PG8_BAR; PG8_SCHED;
            } else {
            PG8_LDB(B0, 0, 0); PG8_SCHED; PG8_LDA(At, 0, 0); PG8_STAGE(PG8_SA(1, 1), a1 + hstep, voffA);
            PG8_WAIT_L(8); PG8_BAR; PG8_WAIT_L(0); PG8_MMA(0, 0, At, B0); PG8_BAR; PG8_SCHED;
            PG8_LDB(B1, 0, 1); PG8_STAGE(PG8_SB(0, 0), b2, voffB);
            PG8_BAR; PG8_WAIT_L(0); PG8_MMA(0, 1, At, B1); PG8_BAR;
            PG8_LDA(At, 0, 1); PG8_STAGE(PG8_SA(0, 0), a2, voffA);
            PG8_BAR; PG8_WAIT_L(0); PG8_MMA(1, 0, At, B0); PG8_BAR; PG8_SCHED;
            PG8_STAGE(PG8_SB(0, 1), b2 + hstep, voffB);
            PG8_WAIT_V(6); PG8_BAR; PG8_MMA(1, 1, At, B1); PG8_BAR;
            PG8_LDB(B0, 1, 0); PG8_SCHED; PG8_LDA(At, 1, 0); PG8_STAGE(PG8_SA(0, 1), a2 + hstep, voffA);
            PG8_WAIT_L(8); PG8_BAR; PG8_WAIT_L(0); PG8_MMA(0, 0, At, B0); PG8_BAR; PG8_SCHED;
            PG8_LDB(B1, 1, 1); PG8_STAGE(PG8_SB(1, 0), b3, voffB);
            PG8_BAR; PG8_WAIT_L(0); PG8_MMA(0, 1, At, B1); PG8_BAR;
            PG8_LDA(At, 1, 1); PG8_STAGE(PG8_SA(1, 0), a3, voffA);
            PG8_BAR; PG8_WAIT_L(0); PG8_MMA(1, 0, At, B0); PG8_BAR; PG8_SCHED;
            PG8_STAGE(PG8_SB(1, 1), b3 + hstep, voffB);
            PG8_WAIT_V(6); PG8_BAR; PG8_MMA(1, 1, At, B1); PG8_BAR;
            }
        }
        if constexpr (ALIGN_EPI) { if (wr == 0) PG8_BAR; }
        if constexpr (!Epi::AFTER_DRAIN) { E(acc, cur, wr, wc, fr, fq); S.done(cur); }
        if (!has_next) break;
#pragma unroll
        for (int a = 0; a < 2; ++a)
#pragma unroll
            for (int b = 0; b < 2; ++b)
#pragma unroll
                for (int m = 0; m < 4; ++m)
#pragma unroll
                    for (int n = 0; n < 2; ++n) acc[a][b][m][n] = (f32x4){0.f, 0.f, 0.f, 0.f};
        cur = nxt; cA = nA; cB = nB; ++ui;
        if constexpr (ALIGN_EPI) { if (wr == 1) PG8_BAR; }
    }
    PG8_WAIT_V(0);
    if constexpr (!ALIGN_EPI) { if (wr == 0) PG8_BAR; }
    PG8_BAR;
    if constexpr (Epi::AFTER_DRAIN) { E.fused(acc, cur, wr, wc, fr, fq, lds, wid, lane); S.done(cur); }
#undef PG8_SA
#undef PG8_SB
#undef PG8_STAGE
#undef PG8_LDA
#undef PG8_LDB
#undef PG8_MMA
#undef PG8_WAIT_V
#undef PG8_WAIT_L
#undef PG8_BAR
#undef PG8_SCHED
}
}
#define PG8_ALIGN true
#ifndef R_SYNC
#define R_SYNC 0
#endif
#ifndef R_P0
#define R_P0 1
#endif
#ifndef R_G1
#define R_G1 1
#endif
#ifndef R_HG
#define R_HG 1
#endif
#ifndef R_G3
#define R_G3 1
#endif
#ifndef R_G45
#define R_G45 1
#endif
#ifndef R_AT
#define R_AT 1
#endif
#define PG8_SP2 true
#define LAS __attribute__((address_space(3)))
typedef unsigned short bf16_t;
typedef float f32x4 __attribute__((ext_vector_type(4)));
typedef unsigned u32x4 __attribute__((ext_vector_type(4)));
typedef unsigned u32x2 __attribute__((ext_vector_type(2)));
using pg8::cvt_pk_bf16;
constexpr int NTOK = 8192, DM = 2048, SEQ = 2048, DI = 4096;
constexpr float EPS = 1e-6f;
constexpr size_t MiB = 1u << 20;
constexpr size_t WS_W2T = 1 * MiB, WS_W3T = 17 * MiB, WS_W4T = 39 * MiB, WS_W5T = 48 * MiB, WS_W6T = 56 * MiB;
constexpr size_t WS_QH = 72 * MiB, WS_VI = 104 * MiB, WS_GS = 168 * MiB, WS_ST = 232 * MiB, WS_W1T = 232 * MiB, WS_XN = 280 * MiB;
constexpr size_t WS_H1B = 72 * MiB, WS_Q = 72 * MiB, WS_KN = 168 * MiB, WS_GATE = 232 * MiB, WS_CQ = 296 * MiB, WS_C = 308 * MiB, WS_KR = 316 * MiB, WS_V = 317 * MiB;
constexpr size_t WS_SS1 = 381 * MiB, WS_SSQ = 382 * MiB, WS_SSC = 382 * MiB + 512 * 1024, WS_SS2 = 383 * MiB, WS_NEED = 384 * MiB;
constexpr int LDS_BYTES = 147456;
constexpr float QSCALE = 0.07216878364870322f * 1.4426950408889634f;

#define XB_TMO      128
#define XB_XCNT(j)  (256  + 64 * (j))
#define XB_XSUB(j)  (1280 + 64 * (j))
#define XB_XGEN(j)  (2304 + 64 * (j))
#define XB_TOP      3328
#define XB_TOPGEN   3392
#define XCD_BAR_WORDS 3456
#define XB_SPIN_CAP (1u << 18)

__device__ __forceinline__ unsigned xb_ld(unsigned* p)              { return __hip_atomic_load(p, __ATOMIC_RELAXED, __HIP_MEMORY_SCOPE_AGENT); }
__device__ __forceinline__ unsigned xb_add(unsigned* p, unsigned v) { return __hip_atomic_fetch_add(p, v, __ATOMIC_RELAXED, __HIP_MEMORY_SCOPE_AGENT); }
__device__ __forceinline__ unsigned xb_xcc_id() { return (unsigned)__builtin_amdgcn_s_getreg((3 << 11) | 20) & 0xFu; }
#define XB_SPIN(cond, bar) do { unsigned _sp = 0; while (cond) { __builtin_amdgcn_s_sleep(1); \
    if ((++_sp & 255u) == 0u) { if (xb_ld(&(bar)[XB_TMO])) break; if (_sp > XB_SPIN_CAP) { atomicAdd(&(bar)[XB_TMO], 1u); break; } } } } while (0)

struct XcdBarrier {
    unsigned* bar; unsigned x;
    volatile LAS unsigned* st;
};

__device__ __forceinline__ XcdBarrier xcd_barrier_post(unsigned* bar, volatile LAS unsigned* st) {
    XcdBarrier b; b.bar = bar; b.x = xb_xcc_id(); b.st = st;
    if (threadIdx.x == 0) (void)xb_add(&bar[XB_XCNT(b.x)], 1u);
    return b;
}
__device__ __forceinline__ void xcd_barrier_complete(unsigned* bar, unsigned x, unsigned& nloc, unsigned& nx) {
    const unsigned G = gridDim.x * gridDim.y * gridDim.z;
    unsigned sum, cnt, mine, sp = 0u;
    for (;;) {
        sum = 0u; cnt = 0u; mine = 0u;
#pragma unroll
        for (unsigned j = 0; j < 16; ++j) { const unsigned c = xb_ld(&bar[XB_XCNT(j)]); sum += c; cnt += (c > 0u) ? 1u : 0u; mine = (j == x) ? c : mine; }
        if (sum == G) break;
        __builtin_amdgcn_s_sleep(1);
        if ((++sp & 255u) == 0u) { if (xb_ld(&bar[XB_TMO])) break; if (sp > XB_SPIN_CAP) { atomicAdd(&bar[XB_TMO], 1u); break; } }
    }
    nloc = mine > 0u ? mine : 1u; nx = cnt > 0u ? cnt : 1u;
}

__device__ __forceinline__ void xcd_barrier(const XcdBarrier& b) {
    asm volatile("s_waitcnt vmcnt(0)" ::: "memory");
    __syncthreads();
    if (threadIdx.x == 0) {
        unsigned* bar = b.bar;
        __builtin_amdgcn_s_waitcnt(0);
        unsigned nloc = b.st[0], nx = b.st[1];
        if (nloc == 0u) { xcd_barrier_complete(bar, b.x, nloc, nx); b.st[0] = nloc; b.st[1] = nx; }
        const unsigned old = xb_add(&bar[XB_XSUB(b.x)], 1u);
        const unsigned gen = old / nloc;
        if (old + 1u == (gen + 1u) * nloc) {
            __builtin_amdgcn_fence(__ATOMIC_RELEASE, "agent");
            asm volatile("s_waitcnt vmcnt(0)" ::: "memory");
            const unsigned og = xb_add(&bar[XB_TOP], 1u);
            const unsigned tg = og / nx;
            if (og + 1u == (tg + 1u) * nx) xb_add(&bar[XB_TOPGEN], 1u);
            else XB_SPIN(xb_ld(&bar[XB_TOPGEN]) == tg, bar);
            __builtin_amdgcn_fence(__ATOMIC_ACQUIRE, "agent");
            xb_add(&bar[XB_XGEN(b.x)], 1u);
            asm volatile("s_waitcnt vmcnt(0)" ::: "memory");
        } else {
            XB_SPIN(xb_ld(&bar[XB_XGEN(b.x)]) == gen, bar);
            __builtin_amdgcn_fence(__ATOMIC_ACQUIRE, "agent");
            asm volatile("s_waitcnt vmcnt(0)" ::: "memory");
        }
    }
    __syncthreads();
}

struct Params {
    const float* x; const float* norm_g; const float* hg_w_in; const float* hg_g_norm; const float* hg_w_out; const float* hg_lb;
    const float* kv_in_norm_g; const float* w_kv_down; const float* kv_norm_g; const float* w_kv_up; const float* mla_w_in; const float* mla_q_norm_g;
    const float* mla_w_q_up; const float* mla_w_out; const float* final_norm_g;
    float* out; unsigned char* ws;
};

__device__ __forceinline__ float bf2f(bf16_t v) { return __uint_as_float((unsigned)v << 16); }
__device__ __forceinline__ float bflo(unsigned u) { return __uint_as_float(u << 16); }
__device__ __forceinline__ float bfhi(unsigned u) { return __uint_as_float(u & 0xffff0000u); }
__device__ __forceinline__ float silu_f(float v) { return v * __builtin_amdgcn_rcpf(1.0f + __builtin_amdgcn_exp2f(-1.4426950408889634f * v)); }
__device__ __forceinline__ float wave_sum(float v) {
#pragma unroll
    for (int o = 1; o < 64; o <<= 1) v += __shfl_xor(v, o);
    return v;
}
__device__ __forceinline__ void store8_bf16(bf16_t* p, const f32x4& a, const f32x4& b) {
    u32x4 w; w.x = cvt_pk_bf16(a[0], a[1]); w.y = cvt_pk_bf16(a[2], a[3]); w.z = cvt_pk_bf16(b[0], b[1]); w.w = cvt_pk_bf16(b[2], b[3]);
    *(u32x4*)p = w;
}
__device__ __forceinline__ void rope8(f32x4& a, f32x4& b, int pos, int j0) {
    float v[8] = {a[0], a[1], a[2], a[3], b[0], b[1], b[2], b[3]};
#pragma unroll
    for (int p = 0; p < 4; ++p) {
        const float inv = __builtin_amdgcn_exp2f(-(float)(j0 + p) * 0.41524101186092029f);
        float rev = (float)pos * inv * 0.15915494309189535f; rev = rev - floorf(rev);
        const float c = __builtin_amdgcn_cosf(rev), s = __builtin_amdgcn_sinf(rev);
        const float x1 = v[2 * p], x2 = v[2 * p + 1];
        v[2 * p] = x1 * c - x2 * s; v[2 * p + 1] = x2 * c + x1 * s;
    }
    a = (f32x4){v[0], v[1], v[2], v[3]}; b = (f32x4){v[4], v[5], v[6], v[7]};
}

typedef const f32x4 (&AccRef)[2][2][4][2];
struct EpiG1 {
    static constexpr bool PERM = true, AFTER_DRAIN = false;
    bf16_t* Qh; float* F; bf16_t* VI; bf16_t* GS;
    __device__ __forceinline__ void operator()(AccRef acc, const pg8::Unit& u, int wr, int wc, int fr, int fq) const {
        const int pn = u.pn;
#pragma unroll
        for (int ai = 0; ai < 2; ++ai)
#pragma unroll
            for (int m = 0; m < 4; ++m) {
                const size_t row = (size_t)(u.pm * 256 + ai * 128 + wr * 64 + m * 16 + fr);
#pragma unroll
                for (int bj = 0; bj < 2; ++bj) {
                    const int col = pn * 256 + bj * 128 + wc * 32 + 8 * fq;
                    f32x4 a = acc[ai][bj][m][0], b = acc[ai][bj][m][1];
                    if (pn < 8) store8_bf16(Qh + row * 2048 + col, a, b);
                    else if (pn < 16) { float* o = F + row * 2048 + (col - 2048); *(f32x4*)o = a; *(f32x4*)(o + 4) = b; }
                    else if (pn < 32) store8_bf16(VI + row * 4096 + (col - 4096), a, b);
                    else {
#pragma unroll
                        for (int j = 0; j < 4; ++j) { a[j] = silu_f(a[j]); b[j] = silu_f(b[j]); }
                        store8_bf16(GS + row * 4096 + (col - 8192), a, b);
                    }
                }
            }
    }
};
template <bool WB> struct EpiRes {
    static constexpr bool PERM = true, AFTER_DRAIN = false;
    const float* base; float* out; bf16_t* outb; float* ss;
    __device__ __forceinline__ void operator()(AccRef acc, const pg8::Unit& u, int wr, int wc, int fr, int fq) const {
#pragma unroll
        for (int ai = 0; ai < 2; ++ai)
#pragma unroll
            for (int m = 0; m < 4; ++m) {
                const size_t row = (size_t)(u.pm * 256 + ai * 128 + wr * 64 + m * 16 + fr);
                float s = 0.f;
#pragma unroll
                for (int bj = 0; bj < 2; ++bj) {
                    const int col = u.pn * 256 + bj * 128 + wc * 32 + 8 * fq;
                    const size_t off = row * 2048 + col;
                    f32x4 a = acc[ai][bj][m][0] + *(const f32x4*)(base + off), b = acc[ai][bj][m][1] + *(const f32x4*)(base + off + 4);
                    *(f32x4*)(out + off) = a; *(f32x4*)(out + off + 4) = b;
                    if (WB) store8_bf16(outb + off, a, b);
                    s += (a[0] * a[0] + a[1] * a[1]) + (a[2] * a[2] + a[3] * a[3]) + (b[0] * b[0] + b[1] * b[1]) + (b[2] * b[2] + b[3] * b[3]);
                }
                s += __shfl_xor(s, 16); s += __shfl_xor(s, 32);
                if (fq == 0) ss[row * 32 + u.pn * 4 + wc] = s;
            }
    }
};
struct EpiG3 {
    static constexpr bool PERM = true, AFTER_DRAIN = false;
    const float* ss1; bf16_t* CQ; bf16_t* GATE; bf16_t* C; bf16_t* KR; float* ssq; float* ssc;
    __device__ __forceinline__ void operator()(AccRef acc, const pg8::Unit& u, int wr, int wc, int fr, int fq) const {
        const int pn = u.pn;
#pragma unroll
        for (int ai = 0; ai < 2; ++ai)
#pragma unroll
            for (int m = 0; m < 4; ++m) {
                const size_t row = (size_t)(u.pm * 256 + ai * 128 + wr * 64 + m * 16 + fr);
                float t = 0.f;
                { const f32x4* sp = (const f32x4*)(ss1 + row * 32);
#pragma unroll
                  for (int i = 0; i < 8; ++i) { const f32x4 q = sp[i]; t += (q[0] + q[1]) + (q[2] + q[3]); } }
                const float rs = __builtin_amdgcn_rsqf(t * (1.0f / 2048.0f) + EPS);
                float s = 0.f;
#pragma unroll
                for (int bj = 0; bj < 2; ++bj) {
                    const int lc = bj * 128 + wc * 32 + 8 * fq;
                    f32x4 a = acc[ai][bj][m][0] * rs, b = acc[ai][bj][m][1] * rs;
                    if (pn < 3) { store8_bf16(CQ + row * 768 + pn * 256 + lc, a, b); }
                    else if (pn < 19) {
#pragma unroll
                        for (int j = 0; j < 4; ++j) { a[j] = silu_f(a[j]); b[j] = silu_f(b[j]); }
                        store8_bf16(GATE + row * 4096 + (pn - 3) * 256 + lc, a, b);
                    } else if (pn < 21) { store8_bf16(C + row * 512 + (pn - 19) * 256 + lc, a, b); }
                    else if (bj == 0 && wc < 2) { rope8(a, b, (int)(row & 2047), wc * 16 + 4 * fq); store8_bf16(KR + row * 64 + lc, a, b); }
                    s += (a[0] * a[0] + a[1] * a[1]) + (a[2] * a[2] + a[3] * a[3]) + (b[0] * b[0] + b[1] * b[1]) + (b[2] * b[2] + b[3] * b[3]);
                }
                s += __shfl_xor(s, 16); s += __shfl_xor(s, 32);
                if (fq == 0) { if (pn < 3) ssq[row * 16 + pn * 4 + wc] = s; else if (pn == 19 || pn == 20) ssc[row * 8 + (pn - 19) * 4 + wc] = s; }
            }
    }
};
struct EpiQ {
    static constexpr bool PERM = true, AFTER_DRAIN = false;
    const float* ssq; bf16_t* Q;
    __device__ __forceinline__ void operator()(AccRef acc, const pg8::Unit& u, int wr, int wc, int fr, int fq) const {
        const int pn = u.pn;
#pragma unroll
        for (int ai = 0; ai < 2; ++ai)
#pragma unroll
            for (int m = 0; m < 4; ++m) {
                const int row = u.pm * 256 + ai * 128 + wr * 64 + m * 16 + fr;
                const f32x4* sp = (const f32x4*)(ssq + (size_t)row * 16);
                const f32x4 q0 = sp[0], q1 = sp[1], q2 = sp[2];
                const float t = ((q0[0] + q0[1]) + (q0[2] + q0[3])) + ((q1[0] + q1[1]) + (q1[2] + q1[3])) + ((q2[0] + q2[1]) + (q2[2] + q2[3]));
                const float rs = __builtin_amdgcn_rsqf(t * (1.0f / 768.0f) + EPS) * QSCALE;
                const int b_ = row >> 11, s_ = row & 2047;
#pragma unroll
                for (int bj = 0; bj < 2; ++bj) {
                    f32x4 a = acc[ai][bj][m][0] * rs, b = acc[ai][bj][m][1] * rs;
                    if (pn < 16) { const int h = pn * 2 + bj; store8_bf16(Q + ((size_t)((b_ * 32 + h) * 2048 + s_)) * 192 + wc * 32 + 8 * fq, a, b); }
                    else { const int h = (pn - 16) * 4 + bj * 2 + (wc >> 1), off = (wc & 1) * 32 + 8 * fq;
                        rope8(a, b, s_, off >> 1); store8_bf16(Q + ((size_t)((b_ * 32 + h) * 2048 + s_)) * 192 + 128 + off, a, b); }
                }
            }
    }
};
struct EpiKV {
    static constexpr bool PERM = true, AFTER_DRAIN = false;
    const float* ssc; bf16_t* KN; bf16_t* V;
    __device__ __forceinline__ void operator()(AccRef acc, const pg8::Unit& u, int wr, int wc, int fr, int fq) const {
        const int h = u.pn;
#pragma unroll
        for (int ai = 0; ai < 2; ++ai)
#pragma unroll
            for (int m = 0; m < 4; ++m) {
                const int row = u.pm * 256 + ai * 128 + wr * 64 + m * 16 + fr;
                const f32x4* sp = (const f32x4*)(ssc + (size_t)row * 8);
                const f32x4 q0 = sp[0], q1 = sp[1];
                const float t = ((q0[0] + q0[1]) + (q0[2] + q0[3])) + ((q1[0] + q1[1]) + (q1[2] + q1[3]));
                const float rs = __builtin_amdgcn_rsqf(t * (1.0f / 512.0f) + EPS);
                const int b_ = row >> 11, s_ = row & 2047;
                const size_t o = ((size_t)((b_ * 32 + h) * 2048 + s_)) * 128 + wc * 32 + 8 * fq;
                store8_bf16(KN + o, acc[ai][0][m][0] * rs, acc[ai][0][m][1] * rs);
                store8_bf16(V + o, acc[ai][1][m][0] * rs, acc[ai][1][m][1] * rs);
            }
    }
};

template <int MODE> __device__ __forceinline__ int src_col(int n) {
    if (MODE == 0) return n;
    if (MODE == 1) { if (n < 512) return n; const int o = n - 512; return 512 + (o >> 1) + 32 * (o & 1); }
    if (n < 4096) return (n >> 7) * 192 + (n & 127);
    const int r = n - 4096, h = r >> 6, o = r & 63; return h * 192 + 128 + (o >> 1) + 32 * (o & 1);
}
template <int MODE> __device__ __forceinline__ void transpose_item(const float* __restrict__ W, int K, int Nsrc, int Nout, const float* __restrict__ gain, bf16_t* WT, int row_off, LAS float* scr, int item, int lane) {
    const int nblk = Nout / 32, kb = item / nblk, nb = item % nblk, k0 = 64 * kb, n0 = 32 * nb;
    const int sc = src_col<MODE>(n0 + (lane & 31));
#pragma unroll 8
    for (int i = 0; i < 32; ++i) { const int kk = 2 * i + (lane >> 5); const float g = gain ? gain[k0 + kk] : 1.0f; scr[kk * 33 + (lane & 31)] = W[(size_t)(k0 + kk) * Nsrc + sc] * g; }
    asm volatile("s_waitcnt lgkmcnt(0)" ::: "memory");
    const int c = lane & 7;
#pragma unroll
    for (int j = 0; j < 4; ++j) { const int n = (lane >> 3) + 8 * j; const LAS float* s = scr + (8 * c) * 33 + n;
        u32x4 o; o.x = cvt_pk_bf16(s[0 * 33], s[1 * 33]); o.y = cvt_pk_bf16(s[2 * 33], s[3 * 33]); o.z = cvt_pk_bf16(s[4 * 33], s[5 * 33]); o.w = cvt_pk_bf16(s[6 * 33], s[7 * 33]);
        *(u32x4*)(WT + (size_t)(row_off + n0 + n) * K + k0 + 8 * c) = o; }
    asm volatile("s_waitcnt lgkmcnt(0)" ::: "memory");
}
__device__ __forceinline__ void phase0(const Params& p, LAS unsigned char* lds, int wave, int lane, int gw, int NGW) {
    LAS float* scr = (LAS float*)(lds + wave * 16384);
    bf16_t* W1T = (bf16_t*)(p.ws + WS_W1T); bf16_t* W2T = (bf16_t*)(p.ws + WS_W2T); bf16_t* W3T = (bf16_t*)(p.ws + WS_W3T);
    bf16_t* W4T = (bf16_t*)(p.ws + WS_W4T); bf16_t* W5T = (bf16_t*)(p.ws + WS_W5T); bf16_t* W6T = (bf16_t*)(p.ws + WS_W6T);
    constexpr int I1 = 32 * 384, I2 = 64 * 64, I3a = 32 * 152, I3b = 32 * 18, I4 = 12 * 192, I5 = 8 * 256, I6 = 64 * 64;
    constexpr int NIT = I1 + I2 + I3a + I3b + I4 + I5 + I6;
    for (int it = gw; it < NIT; it += NGW) {
        int r = it;
        if (r < I1) { transpose_item<0>(p.hg_w_in, 2048, 12288, 12288, p.norm_g, W1T, 0, scr, r, lane); continue; } r -= I1;
        if (r < I2) { transpose_item<0>(p.hg_w_out, 4096, 2048, 2048, nullptr, W2T, 0, scr, r, lane); continue; } r -= I2;
        if (r < I3a) { transpose_item<0>(p.mla_w_in, 2048, 4864, 4864, p.norm_g + 2048, W3T, 0, scr, r, lane); continue; } r -= I3a;
        if (r < I3b) { transpose_item<1>(p.w_kv_down, 2048, 576, 576, p.kv_in_norm_g, W3T, 4864, scr, r, lane); continue; } r -= I3b;
        if (r < I4) { transpose_item<2>(p.mla_w_q_up, 768, 6144, 6144, p.mla_q_norm_g, W4T, 0, scr, r, lane); continue; } r -= I4;
        if (r < I5) { transpose_item<0>(p.w_kv_up, 512, 8192, 8192, p.kv_norm_g, W5T, 0, scr, r, lane); continue; } r -= I5;
        transpose_item<0>(p.mla_w_out, 4096, 2048, 2048, nullptr, W6T, 0, scr, r, lane);
    }
    {
        u32x4* z = (u32x4*)(W3T + (size_t)5440 * 2048);
        for (int i = gw * 64 + lane; i < 192 * 2048 / 8; i += NGW * 64) z[i] = (u32x4){0u, 0u, 0u, 0u};
    }
    bf16_t* XN = (bf16_t*)(p.ws + WS_XN);
    for (int m = gw; m < NTOK; m += NGW) {
        const f32x4* xr = (const f32x4*)(p.x + (size_t)m * 2048) + lane;
        f32x4 v[8]; float s = 0.f;
#pragma unroll
        for (int j = 0; j < 8; ++j) { v[j] = xr[64 * j]; s += (v[j][0] * v[j][0] + v[j][1] * v[j][1]) + (v[j][2] * v[j][2] + v[j][3] * v[j][3]); }
        const float rs = __builtin_amdgcn_rsqf(wave_sum(s) * (1.0f / 2048.0f) + EPS);
        u32x2* o8 = (u32x2*)(XN + (size_t)m * 2048) + lane;
#pragma unroll
        for (int j = 0; j < 8; ++j) { u32x2 w; w.x = cvt_pk_bf16(v[j][0] * rs, v[j][1] * rs); w.y = cvt_pk_bf16(v[j][2] * rs, v[j][3] * rs); o8[64 * j] = w; }
    }
}

__device__ __forceinline__ void hgrn_naive(const Params& p, LAS unsigned char* lds, int tid) {
    if (blockIdx.x >= 64) return;
    const int bh = blockIdx.x, b = bh >> 4, h = bh & 15;
    LAS float* fg = (LAS float*)lds; LAS float* kks = fg + 128; LAS float* qs = kks + 128; LAS float* op = qs + 128; LAS float* red = op + 512;
    const float* F = p.out; const bf16_t* Qh = (const bf16_t*)(p.ws + WS_QH); const bf16_t* VI = (const bf16_t*)(p.ws + WS_VI); bf16_t* GS = (bf16_t*)(p.ws + WS_GS);
    const int v = tid & 255, half = tid >> 8, wave = tid >> 6, lane = tid & 63;
    float S[64];
#pragma unroll
    for (int j = 0; j < 64; ++j) S[j] = 0.f;
    float lb = 0.f;
    if (tid < 128) { const float a = p.hg_lb[h * 128 + tid], bb = p.hg_lb[2048 + h * 128 + tid]; lb = 1.0f / (1.0f + __expf(bb - a)); }
    const float gn = p.hg_g_norm[v];
    for (int t = 0; t < SEQ; ++t) {
        const size_t row = (size_t)b * SEQ + t;
        if (tid < 128) {
            const float f = F[row * 2048 + h * 128 + tid]; const float q = bf2f(Qh[row * 2048 + h * 128 + tid]);
            const float sg = 1.0f / (1.0f + __expf(-f));
            fg[tid] = lb + (1.0f - lb) * sg; kks[tid] = (1.0f - lb) * (1.0f - sg); qs[tid] = q;
        }
        const float iv = bf2f(VI[row * 4096 + h * 256 + v]);
        __syncthreads();
        float o = 0.f;
#pragma unroll
        for (int j = 0; j < 64; ++j) { const int k = half * 64 + j; S[j] = fg[k] * S[j] + kks[k] * iv; o += qs[k] * S[j]; }
        op[half * 256 + v] = o;
        __syncthreads();
        const float of = op[v] + op[256 + v];
        const float sq = wave_sum(of * of);
        if (lane == 0) red[wave] = sq;
        __syncthreads();
        const float tot = (red[0] + red[1]) + (red[2] + red[3]);
        const float rs = __builtin_amdgcn_rsqf(tot * (1.0f / 256.0f) + EPS);
        if (half == 0) { bf16_t* g = GS + row * 4096 + h * 256 + v; const float y = of * rs * gn * bf2f(*g); *g = (bf16_t)(cvt_pk_bf16(y, 0.f) & 0xffffu); }
    }
}

typedef short bf16x8 __attribute__((ext_vector_type(8)));
typedef short s16x4 __attribute__((ext_vector_type(4)));
typedef float f32x16 __attribute__((ext_vector_type(16)));
__device__ __forceinline__ s16x4 tr_read(LAS const unsigned char* p) { return __builtin_bit_cast(s16x4, __builtin_amdgcn_ds_read_tr16_b64_v4i16((LAS s16x4*)p)); }
__device__ __forceinline__ bf16_t f2bf(float x) { return (bf16_t)(cvt_pk_bf16(x, 0.f) & 0xffffu); }
#define HG_BAR() do { asm volatile("s_waitcnt vmcnt(0) lgkmcnt(0)" ::: "memory"); __builtin_amdgcn_s_barrier(); asm volatile("" ::: "memory"); } while (0)
#define HG_BAR_L() do { asm volatile("s_waitcnt lgkmcnt(0)" ::: "memory"); __builtin_amdgcn_s_barrier(); asm volatile("" ::: "memory"); } while (0)
__device__ __forceinline__ void hgrn_state_phase(const Params& p, LAS unsigned char* lds, int tid, int wave, int lane) {
    constexpr int SQT = 0, SDEC = 2048, SKD = 4096, SKDROW = 320, SVT = SKD + 64 * SKDROW, SVTROW = 192;
    const float* F = p.out; const bf16_t* VI = (const bf16_t*)(p.ws + WS_VI); bf16_t* ST = (bf16_t*)(p.ws + WS_ST);
    LAS float* QT = (LAS float*)(lds + SQT); LAS float* DEC = (LAS float*)(lds + SDEC);
    const int r32 = lane & 31, hi = lane >> 5, i16 = lane & 15, g1 = (lane >> 4) & 1;
    const int k = tid & 127, tq = tid >> 7;
    for (int unit = blockIdx.x; unit < 256; unit += gridDim.x) {
        const int bh = unit >> 2, vq = unit & 3, b = bh >> 4, h = bh & 15;
        float lb; { const float a = p.hg_lb[h * 128 + k], bb = p.hg_lb[2048 + h * 128 + k]; lb = 1.0f / (1.0f + __expf(bb - a)); }
        const float oml = 1.0f - lb;
        const float* Fp = F + ((size_t)(b * 2048 + 16 * tq)) * 2048 + h * 128 + k;
        const bf16_t* Vp = VI + ((size_t)(b * 2048 + (tid >> 3))) * 4096 + h * 256 + vq * 64 + (tid & 7) * 8;
        f32x16 acc;
#pragma unroll
        for (int r = 0; r < 16; ++r) acc[r] = 0.f;
        float fr[16]; u32x4 vr;
#pragma unroll
        for (int i = 0; i < 16; ++i) fr[i] = Fp[(size_t)i * 2048];
        vr = *(const u32x4*)Vp;
        const int vi = wave & 1, ki = wave >> 1;
        for (int c = 0; c < 32; ++c) {
            float cs[16], kk[16]; float run = 0.f;
#pragma unroll
            for (int i = 0; i < 16; ++i) {
                const float e = __builtin_amdgcn_exp2f(-1.4426950408889634f * fr[i]); const float sg = __builtin_amdgcn_rcpf(1.0f + e);
                run += __builtin_amdgcn_logf(lb + oml * sg); cs[i] = run; kk[i] = oml * e * sg;
            }
            QT[tq * 128 + k] = run;
            HG_BAR_L();
            const float q0 = QT[k], q1 = QT[128 + k], q2 = QT[256 + k], q3 = QT[384 + k];
            const float off = (tq > 0 ? q0 : 0.f) + (tq > 1 ? q1 : 0.f) + (tq > 2 ? q2 : 0.f), bl = (q0 + q1) + (q2 + q3);
#pragma unroll
            for (int i = 0; i < 16; ++i) *(LAS bf16_t*)(lds + SKD + (16 * tq + i) * SKDROW + k * 2) = f2bf(kk[i] * __builtin_amdgcn_exp2f(bl - (off + cs[i])));
            if (tq == 0) DEC[k] = __builtin_amdgcn_exp2f(bl);
            *(LAS u32x4*)(lds + SVT + (tid >> 3) * SVTROW + (tid & 7) * 16) = vr;
            if (c + 1 < 32) {
                const float* Fn = Fp + (size_t)(c + 1) * 64 * 2048;
#pragma unroll
                for (int i = 0; i < 16; ++i) fr[i] = Fn[(size_t)i * 2048];
                vr = *(const u32x4*)(Vp + (size_t)(c + 1) * 64 * 4096);
            }
            HG_BAR_L();
            {
                bf16_t* sp = ST + ((size_t)((bh * 32 + c) * 256 + vq * 64 + 32 * vi)) * 128 + 32 * ki + r32;
#pragma unroll
                for (int r = 0; r < 16; ++r) sp[(size_t)((r & 3) + 8 * (r >> 2) + 4 * hi) * 128] = f2bf(acc[r]);
                const float dc = DEC[32 * ki + r32];
#pragma unroll
                for (int r = 0; r < 16; ++r) acc[r] *= dc;
                LAS const unsigned char* va = lds + SVT + (8 * hi + (i16 >> 2)) * SVTROW + (32 * vi + 16 * g1 + 4 * (i16 & 3)) * 2;
                LAS const unsigned char* ka = lds + SKD + (8 * hi + (i16 >> 2)) * SKDROW + (32 * ki + 16 * g1 + 4 * (i16 & 3)) * 2;
#pragma unroll
                for (int st = 0; st < 4; ++st) {
                    const s16x4 a0 = tr_read(va + st * 16 * SVTROW), a1 = tr_read(va + st * 16 * SVTROW + 4 * SVTROW);
                    const s16x4 b0 = tr_read(ka + st * 16 * SKDROW), b1 = tr_read(ka + st * 16 * SKDROW + 4 * SKDROW);
                    const bf16x8 af = (bf16x8){a0[0], a0[1], a0[2], a0[3], a1[0], a1[1], a1[2], a1[3]};
                    const bf16x8 bf = (bf16x8){b0[0], b0[1], b0[2], b0[3], b1[0], b1[1], b1[2], b1[3]};
                    acc = __builtin_amdgcn_mfma_f32_32x32x16_bf16(af, bf, acc, 0, 0, 0);
                }
            }
        }
        HG_BAR_L();
    }
}
__device__ __forceinline__ void hgrn_out_phase(const Params& p, LAS unsigned char* lds, int tid, int wave, int lane, int do_store) {
    constexpr int QROW = 272, OQD = 0, OQM = 17408, OKM = 34816, OQO = 52224, OKO = 60928, OVT = 69632, VROW = 576, OPS = 106496, PROW = 144, OQT = 115712, OROW = 1040;
    const float* F = p.out; const bf16_t* Qh = (const bf16_t*)(p.ws + WS_QH); const bf16_t* VI = (const bf16_t*)(p.ws + WS_VI); const bf16_t* ST = (const bf16_t*)(p.ws + WS_ST); bf16_t* GS = (bf16_t*)(p.ws + WS_GS);
    LAS float* QT = (LAS float*)(lds + OQT);
    const int r32 = lane & 31, hi = lane >> 5, i16 = lane & 15, g1 = (lane >> 4) & 1;
    const int k = tid & 127, tq = tid >> 7, th = tq >> 1;
    for (int unit = blockIdx.x; unit < 2048; unit += gridDim.x) {
        const int bh = unit >> 5, c = unit & 31, b = bh >> 4, h = bh & 15, row0 = b * 2048 + c * 64;
        float lb; { const float a = p.hg_lb[h * 128 + k], bb = p.hg_lb[2048 + h * 128 + k]; lb = 1.0f / (1.0f + __expf(bb - a)); }
        const float oml = 1.0f - lb;
        float fr[16]; bf16_t qv[16]; u32x4 vr[4]; bf16x8 sfr[8];
        { const float* Fp = F + ((size_t)(row0 + 16 * tq)) * 2048 + h * 128 + k; const bf16_t* Qp = Qh + ((size_t)(row0 + 16 * tq)) * 2048 + h * 128 + k;
#pragma unroll
          for (int i = 0; i < 16; ++i) { fr[i] = Fp[(size_t)i * 2048]; qv[i] = Qp[(size_t)i * 2048]; } }
#pragma unroll
        for (int j = 0; j < 4; ++j) { const int id = tid + 512 * j; vr[j] = *(const u32x4*)(VI + ((size_t)(row0 + (id >> 5))) * 4096 + h * 256 + (id & 31) * 8); }
        { const bf16_t* sp = ST + ((size_t)((bh * 32 + c) * 256 + 32 * wave + r32)) * 128 + 8 * hi;
#pragma unroll
          for (int s = 0; s < 8; ++s) sfr[s] = *(const bf16x8*)(sp + 16 * s); }
        float cs[16], kk[16]; float run = 0.f;
#pragma unroll
        for (int i = 0; i < 16; ++i) {
            const float e = __builtin_amdgcn_exp2f(-1.4426950408889634f * fr[i]); const float sg = __builtin_amdgcn_rcpf(1.0f + e);
            run += __builtin_amdgcn_logf(lb + oml * sg); cs[i] = run; kk[i] = oml * e * sg;
        }
        QT[tq * 128 + k] = run;
        HG_BAR_L();
        {
            const float q0 = QT[k], q1 = QT[128 + k], q2 = QT[256 + k];
            const float off = (tq > 0 ? q0 : 0.f) + (tq > 1 ? q1 : 0.f) + (tq > 2 ? q2 : 0.f), b31 = q0 + q1, bm = th ? (b31 + q2) : q0;
#pragma unroll
            for (int i = 0; i < 16; ++i) {
                const int t = 16 * tq + i; const float bc = off + cs[i], q = bf2f(qv[i]);
                *(LAS bf16_t*)(lds + OQD + t * QROW + k * 2) = f2bf(q * __builtin_amdgcn_exp2f(bc));
                *(LAS bf16_t*)(lds + OQM + t * QROW + k * 2) = f2bf(q * __builtin_amdgcn_exp2f(bc - bm));
                *(LAS bf16_t*)(lds + OKM + t * QROW + k * 2) = f2bf(kk[i] * __builtin_amdgcn_exp2f(bm - bc));
                if (th) *(LAS bf16_t*)(lds + OQO + (t - 32) * QROW + k * 2) = f2bf(q * __builtin_amdgcn_exp2f(bc - b31));
                else *(LAS bf16_t*)(lds + OKO + t * QROW + k * 2) = f2bf(kk[i] * __builtin_amdgcn_exp2f(b31 - bc));
            }
        }
#pragma unroll
        for (int j = 0; j < 4; ++j) { const int id = tid + 512 * j; *(LAS u32x4*)(lds + OVT + (id >> 5) * VROW + (id & 31) * 16) = vr[j]; }
        HG_BAR_L();
        if (wave < 3) {
            const int abase = (wave == 2 ? OQO : OQM) + (wave == 1 ? 32 * QROW : 0), bbase = (wave == 2 ? OKO : OKM) + (wave == 1 ? 32 * QROW : 0);
            LAS const unsigned char* ap = lds + abase + r32 * QROW + hi * 16; LAS const unsigned char* bp = lds + bbase + r32 * QROW + hi * 16;
            f32x16 pc;
#pragma unroll
            for (int r = 0; r < 16; ++r) pc[r] = 0.f;
#pragma unroll
            for (int s = 0; s < 8; ++s) pc = __builtin_amdgcn_mfma_f32_32x32x16_bf16(*(LAS const bf16x8*)(ap + 32 * s), *(LAS const bf16x8*)(bp + 32 * s), pc, 0, 0, 0);
            const int tb = (wave == 0 ? 0 : 32), sb = (wave == 1 ? 32 : 0);
#pragma unroll
            for (int r = 0; r < 16; ++r) { const int tl = (r & 3) + 8 * (r >> 2) + 4 * hi; float v = pc[r]; if (wave < 2 && r32 > tl) v = 0.f;
                *(LAS bf16_t*)(lds + OPS + (tb + tl) * PROW + (sb + r32) * 2) = f2bf(v); }
        }
        HG_BAR_L();
        f32x16 a0, a1;
#pragma unroll
        for (int r = 0; r < 16; ++r) { a0[r] = 0.f; a1[r] = 0.f; }
        {
            LAS const unsigned char* qp = lds + OQD + r32 * QROW + hi * 16;
#pragma unroll
            for (int s = 0; s < 8; ++s) {
                a0 = __builtin_amdgcn_mfma_f32_32x32x16_bf16(*(LAS const bf16x8*)(qp + 32 * s), sfr[s], a0, 0, 0, 0);
                a1 = __builtin_amdgcn_mfma_f32_32x32x16_bf16(*(LAS const bf16x8*)(qp + 32 * QROW + 32 * s), sfr[s], a1, 0, 0, 0);
            }
            LAS const unsigned char* vp = lds + OVT + (8 * hi + (i16 >> 2)) * VROW + (32 * wave + 16 * g1 + 4 * (i16 & 3)) * 2;
            LAS const unsigned char* pp = lds + OPS + r32 * PROW + hi * 16;
#pragma unroll
            for (int st = 0; st < 4; ++st) {
                const s16x4 v0 = tr_read(vp + st * 16 * VROW), v1 = tr_read(vp + st * 16 * VROW + 4 * VROW);
                const bf16x8 vf = (bf16x8){v0[0], v0[1], v0[2], v0[3], v1[0], v1[1], v1[2], v1[3]};
                if (st < 2) a0 = __builtin_amdgcn_mfma_f32_32x32x16_bf16(*(LAS const bf16x8*)(pp + 32 * st), vf, a0, 0, 0, 0);
                a1 = __builtin_amdgcn_mfma_f32_32x32x16_bf16(*(LAS const bf16x8*)(pp + 32 * PROW + 32 * st), vf, a1, 0, 0, 0);
            }
        }
        HG_BAR_L();
#pragma unroll
        for (int r = 0; r < 16; ++r) { const int tl = (r & 3) + 8 * (r >> 2) + 4 * hi;
            *(LAS float*)(lds + tl * OROW + (32 * wave + r32) * 4) = a0[r]; *(LAS float*)(lds + (32 + tl) * OROW + (32 * wave + r32) * 4) = a1[r]; }
        HG_BAR_L();
        {
            const int t = tid >> 3, seg = tid & 7;
            f32x4 ov[8]; float ssq = 0.f;
#pragma unroll
            for (int j = 0; j < 8; ++j) { ov[j] = *(LAS const f32x4*)(lds + t * OROW + seg * 128 + j * 16); ssq += (ov[j][0] * ov[j][0] + ov[j][1] * ov[j][1]) + (ov[j][2] * ov[j][2] + ov[j][3] * ov[j][3]); }
            ssq += __shfl_xor(ssq, 1); ssq += __shfl_xor(ssq, 2); ssq += __shfl_xor(ssq, 4);
            const float rs = __builtin_amdgcn_rsqf(ssq * (1.0f / 256.0f) + EPS);
            bf16_t* gp = GS + ((size_t)(row0 + t)) * 4096 + h * 256 + seg * 32; const f32x4* gn = (const f32x4*)(p.hg_g_norm + seg * 32);
#pragma unroll
            for (int j = 0; j < 4; ++j) {
                const u32x4 g = *(const u32x4*)(gp + 8 * j); const f32x4 n0 = gn[2 * j], n1 = gn[2 * j + 1]; const f32x4 x0 = ov[2 * j] * rs * n0, x1 = ov[2 * j + 1] * rs * n1;
                u32x4 w; w.x = cvt_pk_bf16(x0[0] * bflo(g.x), x0[1] * bfhi(g.x)); w.y = cvt_pk_bf16(x0[2] * bflo(g.y), x0[3] * bfhi(g.y));
                w.z = cvt_pk_bf16(x1[0] * bflo(g.z), x1[1] * bfhi(g.z)); w.w = cvt_pk_bf16(x1[2] * bflo(g.w), x1[3] * bfhi(g.w));
                if (do_store) *(u32x4*)(gp + 8 * j) = w;
            }
        }
    }
    HG_BAR_L();
}

__device__ __forceinline__ float dot2(unsigned a, unsigned b) { return bflo(a) * bflo(b) + bfhi(a) * bfhi(b); }
__device__ __forceinline__ void attn_naive(const Params& p, int gw, int NGW, int lane) {
    const bf16_t* Q = (const bf16_t*)(p.ws + WS_Q); const bf16_t* KN = (const bf16_t*)(p.ws + WS_KN); const bf16_t* KR = (const bf16_t*)(p.ws + WS_KR);
    const bf16_t* V = (const bf16_t*)(p.ws + WS_V); bf16_t* GATE = (bf16_t*)(p.ws + WS_GATE);
    for (int unit = gw; unit < 16384; unit += NGW) {
        const int quar = unit & 3, qblk = (unit >> 2) & 31, bh = unit >> 7, b = bh >> 5, h = bh & 31;
        const int qi = qblk * 64 + lane;
        unsigned qr[96];
        { const u32x4* qp = (const u32x4*)(Q + ((size_t)(bh * 2048 + qi)) * 192);
#pragma unroll
          for (int i = 0; i < 24; ++i) { const u32x4 t = qp[i]; qr[4 * i] = t.x; qr[4 * i + 1] = t.y; qr[4 * i + 2] = t.z; qr[4 * i + 3] = t.w; } }
        float o[32];
#pragma unroll
        for (int d = 0; d < 32; ++d) o[d] = 0.f;
        float mx = -1e30f, l = 0.f;
        const int jmax = qblk * 64 + 63;
        for (int j = 0; j <= jmax; ++j) {
            const u32x4* kp = (const u32x4*)(KN + ((size_t)(bh * 2048 + j)) * 128);
            const u32x4* rp = (const u32x4*)(KR + ((size_t)(b * 2048 + j)) * 64);
            float s = 0.f;
#pragma unroll
            for (int i = 0; i < 96; ++i) asm volatile("" : "+v"(qr[i]));
#pragma unroll
            for (int i = 0; i < 16; ++i) { const u32x4 kv = kp[i]; s += dot2(qr[4 * i], kv.x) + dot2(qr[4 * i + 1], kv.y) + dot2(qr[4 * i + 2], kv.z) + dot2(qr[4 * i + 3], kv.w); if ((i & 3) == 3) asm volatile("" ::: "memory"); }
#pragma unroll
            for (int i = 0; i < 8; ++i) { const u32x4 kv = rp[i]; s += dot2(qr[64 + 4 * i], kv.x) + dot2(qr[64 + 4 * i + 1], kv.y) + dot2(qr[64 + 4 * i + 2], kv.z) + dot2(qr[64 + 4 * i + 3], kv.w); if ((i & 3) == 3) asm volatile("" ::: "memory"); }
            if (j <= qi) {
                if (s > mx) { const float al = __builtin_amdgcn_exp2f(mx - s); l *= al;
#pragma unroll
                    for (int d = 0; d < 32; ++d) o[d] *= al;
                    mx = s; }
                const float pe = __builtin_amdgcn_exp2f(s - mx); l += pe;
                const u32x4* vp = (const u32x4*)(V + ((size_t)(bh * 2048 + j)) * 128 + quar * 32);
#pragma unroll
                for (int i = 0; i < 4; ++i) { const u32x4 vv = vp[i];
                    o[8 * i] += pe * bflo(vv.x); o[8 * i + 1] += pe * bfhi(vv.x); o[8 * i + 2] += pe * bflo(vv.y); o[8 * i + 3] += pe * bfhi(vv.y);
                    o[8 * i + 4] += pe * bflo(vv.z); o[8 * i + 5] += pe * bfhi(vv.z); o[8 * i + 6] += pe * bflo(vv.w); o[8 * i + 7] += pe * bfhi(vv.w); }
            }
        }
        const float il = 1.0f / l;
        u32x4* gp = (u32x4*)(GATE + ((size_t)(b * 2048 + qi)) * 4096 + h * 128 + quar * 32);
#pragma unroll
        for (int i = 0; i < 4; ++i) { const u32x4 g = gp[i]; u32x4 w;
            w.x = cvt_pk_bf16(o[8 * i] * il * bflo(g.x), o[8 * i + 1] * il * bfhi(g.x)); w.y = cvt_pk_bf16(o[8 * i + 2] * il * bflo(g.y), o[8 * i + 3] * il * bfhi(g.y));
            w.z = cvt_pk_bf16(o[8 * i + 4] * il * bflo(g.z), o[8 * i + 5] * il * bfhi(g.z)); w.w = cvt_pk_bf16(o[8 * i + 6] * il * bflo(g.w), o[8 * i + 7] * il * bfhi(g.w));
            gp[i] = w; }
    }
}

constexpr int AT_KROW = 400, AT_VROW = 320, AT_KB = 64 * AT_KROW, AT_VB = 64 * AT_VROW, AT_STAGE = AT_KB + AT_VB, AT_WSF = 2 * AT_STAGE;
__device__ __forceinline__ void attn_unit(int bh, int qb, const bf16_t* __restrict__ Q, const bf16_t* __restrict__ KN, const bf16_t* __restrict__ KR, const bf16_t* __restrict__ V, bf16_t* GATE,
                                          LAS unsigned char* lds, int tid, int wave, int lane, int do_store) {
    const int r32 = lane & 31, hi = lane >> 5, b = bh >> 5, h = bh & 31;
    const int q0 = qb * 256, NT = 4 * (qb + 1);
    LAS float* wsf = (LAS float*)(lds + AT_WSF) + wave * 32;
    const int krow = tid >> 4, kc = tid & 15, rrow = tid >> 3, rc = tid & 7;
    const bf16_t* kn_src = KN + ((size_t)(bh * 2048 + krow)) * 128 + kc * 8;
    const bf16_t* kr_src = KR + ((size_t)(b * 2048 + rrow)) * 64 + rc * 8;
    const bf16_t* v_src = V + ((size_t)(bh * 2048 + krow)) * 128 + kc * 8;
    const int kn_dst = krow * AT_KROW + kc * 16, kr_dst = rrow * AT_KROW + 256 + rc * 16, v_dst = AT_KB + krow * AT_VROW + kc * 16;
    u32x4 sk0, sk1, skr, sv0, sv1;
#define AT_LOAD(t) do { const size_t o_ = (size_t)(t) * 64 * 128; sk0 = *(const u32x4*)(kn_src + o_); sk1 = *(const u32x4*)(kn_src + o_ + 32 * 128); skr = *(const u32x4*)(kr_src + (size_t)(t) * 64 * 64); \
        sv0 = *(const u32x4*)(v_src + o_); sv1 = *(const u32x4*)(v_src + o_ + 32 * 128); } while (0)
#define AT_WRITE(bufoff) do { LAS unsigned char* d_ = lds + (bufoff); *(LAS u32x4*)(d_ + kn_dst) = sk0; *(LAS u32x4*)(d_ + kn_dst + 32 * AT_KROW) = sk1; *(LAS u32x4*)(d_ + kr_dst) = skr; \
        *(LAS u32x4*)(d_ + v_dst) = sv0; *(LAS u32x4*)(d_ + v_dst + 32 * AT_VROW) = sv1; } while (0)
    AT_LOAD(0);
    bf16x8 qf[12];
    { const bf16_t* qrow = Q + ((size_t)(bh * 2048 + q0 + wave * 32 + r32)) * 192 + hi * 8;
#pragma unroll
      for (int k = 0; k < 12; ++k) qf[k] = *(const bf16x8*)(qrow + 16 * k); }
    f32x16 o[4];
#pragma unroll
    for (int d = 0; d < 4; ++d)
#pragma unroll
        for (int r = 0; r < 16; ++r) o[d][r] = 0.f;
    float mrun = -1e30f, lrun = 0.f;
    AT_WRITE(0);
    if (NT > 1) AT_LOAD(1);
    asm volatile("s_waitcnt lgkmcnt(0)" ::: "memory"); __builtin_amdgcn_s_barrier(); asm volatile("" ::: "memory");
    const int ka_off = r32 * AT_KROW + hi * 16;
    const int i16 = lane & 15, g1 = (lane >> 4) & 1;
    const int va_off = AT_KB + (4 * hi + (i16 >> 2)) * AT_VROW + (16 * g1 + 4 * (i16 & 3)) * 2;
    const int qloc = 32 * wave + r32;
    for (int t = 0; t < NT; ++t) {
        const int cur = (t & 1) * AT_STAGE;
        const int kvrel = 64 * t - q0;
        if (kvrel <= 32 * wave + 31) {
            LAS const unsigned char* kp = lds + cur + ka_off;
            f32x16 p0, p1;
#pragma unroll
            for (int r = 0; r < 16; ++r) { p0[r] = 0.f; p1[r] = 0.f; }
#pragma unroll
            for (int k = 0; k < 12; ++k) {
                const bf16x8 a0 = *(LAS const bf16x8*)(kp + k * 32), a1 = *(LAS const bf16x8*)(kp + 32 * AT_KROW + k * 32);
                p0 = __builtin_amdgcn_mfma_f32_32x32x16_bf16(a0, qf[k], p0, 0, 0, 0);
                p1 = __builtin_amdgcn_mfma_f32_32x32x16_bf16(a1, qf[k], p1, 0, 0, 0);
                if ((k % 3) == 2) asm volatile("" ::: "memory");
            }
            if (kvrel + 63 > 32 * wave) {
#pragma unroll
                for (int r = 0; r < 16; ++r) { const int kv = kvrel + (r & 3) + 8 * (r >> 2) + 4 * hi;
                    if (kv > qloc) p0[r] = -INFINITY; if (kv + 32 > qloc) p1[r] = -INFINITY; }
            }
            float rm = fmaxf(p0[0], p1[0]);
#pragma unroll
            for (int r = 1; r < 16; ++r) rm = fmaxf(rm, fmaxf(p0[r], p1[r]));
            rm = fmaxf(rm, __shfl_xor(rm, 32));
            if (__any(rm > mrun + 8.0f)) {
                const float mn = fmaxf(mrun, rm), al = __builtin_amdgcn_exp2f(mrun - mn);
                mrun = mn; lrun *= al;
                if (hi == 0) wsf[r32] = al;
                asm volatile("s_waitcnt lgkmcnt(0)" ::: "memory");
#pragma unroll
                for (int g = 0; g < 4; ++g) { const f32x4 a4 = *(LAS const f32x4*)(wsf + 8 * g + 4 * hi);
#pragma unroll
                    for (int d = 0; d < 4; ++d) { o[d][4 * g] *= a4[0]; o[d][4 * g + 1] *= a4[1]; o[d][4 * g + 2] *= a4[2]; o[d][4 * g + 3] *= a4[3]; } }
            }
            float ls = 0.f;
#pragma unroll
            for (int r = 0; r < 16; ++r) { p0[r] = __builtin_amdgcn_exp2f(p0[r] - mrun); p1[r] = __builtin_amdgcn_exp2f(p1[r] - mrun); ls += p0[r] + p1[r]; }
            lrun += ls;
            bf16x8 pa[4];
#pragma unroll
            for (int s2 = 0; s2 < 2; ++s2) {
                u32x4 w0, w1;
                w0.x = cvt_pk_bf16(p0[8 * s2], p0[8 * s2 + 1]); w0.y = cvt_pk_bf16(p0[8 * s2 + 2], p0[8 * s2 + 3]); w0.z = cvt_pk_bf16(p0[8 * s2 + 4], p0[8 * s2 + 5]); w0.w = cvt_pk_bf16(p0[8 * s2 + 6], p0[8 * s2 + 7]);
                w1.x = cvt_pk_bf16(p1[8 * s2], p1[8 * s2 + 1]); w1.y = cvt_pk_bf16(p1[8 * s2 + 2], p1[8 * s2 + 3]); w1.z = cvt_pk_bf16(p1[8 * s2 + 4], p1[8 * s2 + 5]); w1.w = cvt_pk_bf16(p1[8 * s2 + 6], p1[8 * s2 + 7]);
                pa[s2] = __builtin_bit_cast(bf16x8, w0); pa[2 + s2] = __builtin_bit_cast(bf16x8, w1);
            }
            LAS const unsigned char* vp = lds + cur + va_off;
#pragma unroll
            for (int s = 0; s < 4; ++s) {
                const int rb = (16 * (s & 1) + 32 * (s >> 1)) * AT_VROW;
#pragma unroll
                for (int d = 0; d < 4; ++d) {
                    const s16x4 lo = tr_read(vp + rb + d * 64), hh = tr_read(vp + rb + 8 * AT_VROW + d * 64);
                    const bf16x8 vf = (bf16x8){lo[0], lo[1], lo[2], lo[3], hh[0], hh[1], hh[2], hh[3]};
                    o[d] = __builtin_amdgcn_mfma_f32_32x32x16_bf16(pa[s], vf, o[d], 0, 0, 0);
                }
                asm volatile("" ::: "memory");
            }
        }
        if (t + 1 < NT) AT_WRITE(((t + 1) & 1) * AT_STAGE);
        asm volatile("s_waitcnt lgkmcnt(0)" ::: "memory"); __builtin_amdgcn_s_barrier(); asm volatile("" ::: "memory");
        if (t + 2 < NT) AT_LOAD(t + 2);
    }
    lrun += __shfl_xor(lrun, 32);
    if (hi == 0) wsf[r32] = 1.0f / lrun;
    asm volatile("s_waitcnt lgkmcnt(0)" ::: "memory");
#pragma unroll
    for (int g = 0; g < 4; ++g) {
        const f32x4 li = *(LAS const f32x4*)(wsf + 8 * g + 4 * hi);
#pragma unroll
        for (int i = 0; i < 4; ++i) {
            const int row = q0 + 32 * wave + 8 * g + 4 * hi + i;
            bf16_t* gp = GATE + ((size_t)(b * 2048 + row)) * 4096 + h * 128 + r32;
#pragma unroll
            for (int d = 0; d < 4; ++d) { const float y = o[d][4 * g + i] * li[i] * bf2f(gp[32 * d]); if (do_store) gp[32 * d] = (bf16_t)(cvt_pk_bf16(y, 0.f) & 0xffffu); }
        }
    }
#undef AT_LOAD
#undef AT_WRITE
}
__device__ __forceinline__ void attn_phase(const Params& p, LAS unsigned char* lds, int tid, int wave, int lane, int do_store) {
    const bf16_t* Q = (const bf16_t*)(p.ws + WS_Q); const bf16_t* KN = (const bf16_t*)(p.ws + WS_KN); const bf16_t* KR = (const bf16_t*)(p.ws + WS_KR);
    const bf16_t* V = (const bf16_t*)(p.ws + WS_V); bf16_t* GATE = (bf16_t*)(p.ws + WS_GATE);
    for (int pi = blockIdx.x; pi < 512; pi += gridDim.x) {
        const int bh = pi >> 2, pp = pi & 3;
        attn_unit(bh, 7 - pp, Q, KN, KR, V, GATE, lds, tid, wave, lane, do_store);
        attn_unit(bh, pp, Q, KN, KR, V, GATE, lds, tid, wave, lane, do_store);
    }
}

__device__ __forceinline__ void final_norm(const Params& p, int gw, int NGW, int lane) {
    const float* ss2 = (const float*)(p.ws + WS_SS2);
    for (int m = gw; m < NTOK; m += NGW) {
        const float t = wave_sum(lane < 32 ? ss2[(size_t)m * 32 + lane] : 0.f);
        const float rs = __builtin_amdgcn_rsqf(t * (1.0f / 2048.0f) + EPS);
        f32x4* xr = (f32x4*)(p.out + (size_t)m * 2048) + lane; const f32x4* gr = (const f32x4*)p.final_norm_g + lane;
#pragma unroll
        for (int j = 0; j < 8; ++j) { const f32x4 v = xr[64 * j], g = gr[64 * j]; xr[64 * j] = v * rs * g; }
    }
}

__global__ void __launch_bounds__(512) yoco_fwd(Params p) {
    extern __shared__ __attribute__((aligned(16))) unsigned char lds_raw[];
    LAS unsigned char* lds = (LAS unsigned char*)lds_raw;
    cg::grid_group grid = cg::this_grid();
    { volatile LAS unsigned* m_ = (volatile LAS unsigned*)(lds + 131072 + 320); if (threadIdx.x < 32) m_[threadIdx.x] = 0u; }
    __syncthreads();
    XcdBarrier xbar = xcd_barrier_post((unsigned*)p.ws + 4096, (volatile LAS unsigned*)(lds + 131072 + 320) + 8);
    const int wave = __builtin_amdgcn_readfirstlane(threadIdx.x >> 6);
    const int G = gridDim.x, gw = blockIdx.x * 8 + wave, NGW = G * 8;
    unsigned char* ws = p.ws;
    for (int rep = 0; rep < R_SYNC; ++rep) grid.sync();
    for (int rep = 0; rep < R_P0; ++rep) phase0(p, lds, wave, pg8::pg8_lane_id(), gw, NGW);
    grid.sync();
    for (int rep = 0; rep < R_G1; ++rep)
    { pg8::Gemm g{(const bf16_t*)(ws + WS_XN), (const bf16_t*)(ws + WS_W1T), NTOK, 12288, 2048}; pg8::StaticOrder S; S.init(NTOK, 12288, G, (int)blockIdx.x);
      EpiG1 E{(bf16_t*)(ws + WS_QH), p.out, (bf16_t*)(ws + WS_VI), (bf16_t*)(ws + WS_GS)};
      pg8::gemm_phase<EpiG1, pg8::StaticOrder, PG8_ALIGN, PG8_SP2>(lds, g, S, E, wave); }
    xcd_barrier(xbar);
    for (int rep = 0; rep < R_HG; ++rep) { const int l_ = pg8::pg8_lane_id(); hgrn_state_phase(p, lds, wave * 64 + l_, wave, l_); }
    xcd_barrier(xbar);
    for (int rep = 0; rep < R_HG; ++rep) { const int l_ = pg8::pg8_lane_id(); hgrn_out_phase(p, lds, wave * 64 + l_, wave, l_, rep == R_HG - 1); }
    xcd_barrier(xbar);
    { pg8::Gemm g{(const bf16_t*)(ws + WS_GS), (const bf16_t*)(ws + WS_W2T), NTOK, 2048, 4096}; pg8::StaticOrder S; S.init(NTOK, 2048, G, (int)blockIdx.x);
      EpiRes<true> E{p.x, p.out, (bf16_t*)(ws + WS_H1B), (float*)(ws + WS_SS1)};
      pg8::gemm_phase<EpiRes<true>, pg8::StaticOrder, PG8_ALIGN, PG8_SP2>(lds, g, S, E, wave); }
    xcd_barrier(xbar);
    for (int rep = 0; rep < R_G3; ++rep)
    { pg8::Gemm g{(const bf16_t*)(ws + WS_H1B), (const bf16_t*)(ws + WS_W3T), NTOK, 5632, 2048}; pg8::StaticOrder S; S.init(NTOK, 5632, G, (int)blockIdx.x);
      EpiG3 E{(const float*)(ws + WS_SS1), (bf16_t*)(ws + WS_CQ), (bf16_t*)(ws + WS_GATE), (bf16_t*)(ws + WS_C), (bf16_t*)(ws + WS_KR), (float*)(ws + WS_SSQ), (float*)(ws + WS_SSC)};
      pg8::gemm_phase<EpiG3, pg8::StaticOrder, PG8_ALIGN, PG8_SP2>(lds, g, S, E, wave); }
    xcd_barrier(xbar);
    for (int rep = 0; rep < R_G45; ++rep) {
    { pg8::Gemm g{(const bf16_t*)(ws + WS_CQ), (const bf16_t*)(ws + WS_W4T), NTOK, 6144, 768}; pg8::StaticOrder S; S.init(NTOK, 6144, G, (int)blockIdx.x);
      EpiQ E{(const float*)(ws + WS_SSQ), (bf16_t*)(ws + WS_Q)};
      pg8::gemm_phase<EpiQ, pg8::StaticOrder, PG8_ALIGN, PG8_SP2>(lds, g, S, E, wave); }
    { pg8::Gemm g{(const bf16_t*)(ws + WS_C), (const bf16_t*)(ws + WS_W5T), NTOK, 8192, 512}; pg8::StaticOrder S; S.init(NTOK, 8192, G, (int)blockIdx.x);
      EpiKV E{(const float*)(ws + WS_SSC), (bf16_t*)(ws + WS_KN), (bf16_t*)(ws + WS_V)};
      pg8::gemm_phase<EpiKV, pg8::StaticOrder, PG8_ALIGN, PG8_SP2>(lds, g, S, E, wave); }
    }
    xcd_barrier(xbar);
    for (int rep = 0; rep < R_AT; ++rep) { const int l_ = pg8::pg8_lane_id(); attn_phase(p, lds, wave * 64 + l_, wave, l_, rep == R_AT - 1); }
    xcd_barrier(xbar);
    { pg8::Gemm g{(const bf16_t*)(ws + WS_GATE), (const bf16_t*)(ws + WS_W6T), NTOK, 2048, 4096}; pg8::StaticOrder S; S.init(NTOK, 2048, G, (int)blockIdx.x);
      EpiRes<false> E{p.out, p.out, nullptr, (float*)(ws + WS_SS2)};
      pg8::gemm_phase<EpiRes<false>, pg8::StaticOrder, PG8_ALIGN, PG8_SP2>(lds, g, S, E, wave); }
    xcd_barrier(xbar);
    final_norm(p, gw, NGW, pg8::pg8_lane_id());
}

extern "C" void kernel_launch(void* const* d_in, const int* in_sizes, int n_in, void* d_out, int out_size, void* d_ws, size_t ws_size, hipStream_t stream) {
    static int grid = 0;
    if (grid == 0) {
        if (n_in != 15 || out_size != NTOK * DM || ws_size < WS_NEED) { fprintf(stderr, "kernel_launch: unexpected shapes (n_in %d out %d ws %zu)\n", n_in, out_size, ws_size); grid = -1; return; }
        int dev = 0, cus = 0, per_cu = 0;
        hipGetDevice(&dev); hipDeviceGetAttribute(&cus, hipDeviceAttributeMultiprocessorCount, dev);
        hipFuncSetAttribute((const void*)yoco_fwd, hipFuncAttributeMaxDynamicSharedMemorySize, LDS_BYTES);
        hipOccupancyMaxActiveBlocksPerMultiprocessor(&per_cu, (const void*)yoco_fwd, 512, LDS_BYTES);
        if (per_cu < 1) per_cu = 1;
        (void)hipGetLastError();
        grid = cus * per_cu;
    }
    if (grid < 0) return;
    Params p{};
    p.x = (const float*)d_in[0]; p.norm_g = (const float*)d_in[1]; p.hg_w_in = (const float*)d_in[2]; p.hg_g_norm = (const float*)d_in[3]; p.hg_w_out = (const float*)d_in[4];
    p.hg_lb = (const float*)d_in[5]; p.kv_in_norm_g = (const float*)d_in[6]; p.w_kv_down = (const float*)d_in[7]; p.kv_norm_g = (const float*)d_in[8]; p.w_kv_up = (const float*)d_in[9];
    p.mla_w_in = (const float*)d_in[10]; p.mla_q_norm_g = (const float*)d_in[11]; p.mla_w_q_up = (const float*)d_in[12]; p.mla_w_out = (const float*)d_in[13]; p.final_norm_g = (const float*)d_in[14];
    p.out = (float*)d_out; p.ws = (unsigned char*)d_ws;
    if (hipMemsetAsync(d_ws, 0, 65536, stream) != hipSuccess) { fprintf(stderr, "memset failed\n"); return; }
    void* args[] = {&p};
    hipError_t e = hipLaunchCooperativeKernel((const void*)yoco_fwd, dim3(grid), dim3(512), args, LDS_BYTES, stream);
    if (e != hipSuccess) fprintf(stderr, "cooperative launch failed: %s (grid %d)\n", hipGetErrorString(e), grid);
}
```

```cpp
#include <hip/hip_runtime.h>
#include <hip/hip_cooperative_groups.h>
#include <cstdio>
#include <cstdint>
namespace cg = cooperative_groups;
namespace pg8 {
#define PG8_LAS __attribute__((address_space(3)))
typedef unsigned short bf16_t;
typedef short bf16x8 __attribute__((ext_vector_type(8)));
typedef float f32x4 __attribute__((ext_vector_type(4)));
typedef unsigned u32x4 __attribute__((ext_vector_type(4)));
constexpr int BM = 256, BK = 64, HALF = 128, HTB = HALF * BK * 2  , STAGE_BYTES = 8 * HTB, NXCD = 8, WGM = 8;

__host__ __device__ __forceinline__ int lds_byte(int r, int c) { const int st = (r >> 4) * 2 + (c >> 5), rr = r & 15, cc = c & 31, ob = rr * 64 + cc * 2; return st * 1024 + (ob ^ (((ob >> 9) & 1) << 5)); }
__host__ __device__ __forceinline__ void stage_rc(int b, int& R, int& C) { const int st = b / 1024, sb = b % 1024, swz = sb ^ (((sb >> 9) & 1) << 5); R = (st >> 1) * 16 + swz / 64; C = (st & 1) * 32 + (swz % 64) / 2; }
__host__ __device__ __forceinline__ int perm32(int rho) { const int n = rho >> 4, i = rho & 15; return 8 * (i >> 2) + 4 * n + (i & 3); }

struct Unit { int pm, pn; };
struct Gemm { const bf16_t* A; const bf16_t* Bt; int M, N, K; };

struct StaticOrder {
    int nM, nN, nwg, G, c;
    __host__ __device__ void init(int M, int N, int G_, int c_) { nM = M / BM; nN = N / BM; nwg = nM * nN; G = G_; c = c_; }
    __host__ __device__ bool next(int i, Unit& u) const {
        const long L = (long)i * G + c; if (L >= nwg) return false;
        int wgid = (int)L; { const int q = nwg / NXCD, r = nwg % NXCD, xcd = wgid % NXCD, off = wgid / NXCD; wgid = (xcd < r ? xcd * (q + 1) : r * (q + 1) + (xcd - r) * q) + off; }
        const int nig = WGM * nN, gid = wgid / nig, fm = gid * WGM, gsz = (nM - fm) < WGM ? (nM - fm) : WGM;
        u.pm = fm + ((wgid % nig) % gsz); u.pn = (wgid % nig) / gsz; return true;
    }
    __device__ __forceinline__ void a_ready(const Unit&) const {}
    __device__ __forceinline__ void done(const Unit&) const {}
};

__device__ __forceinline__ unsigned cvt_pk_bf16(float lo, float hi) { unsigned r; asm volatile("v_cvt_pk_bf16_f32 %0, %1, %2" : "=v"(r) : "v"(lo), "v"(hi)); return r; }
__device__ __forceinline__ int pg8_lane_id() { int l; asm volatile("v_mbcnt_lo_u32_b32 %0, -1, 0\n\tv_mbcnt_hi_u32_b32 %0, -1, %0" : "=v"(l)); return l; }
template <class Epi, class Sched, bool ALIGN_EPI = false, bool SP2 = false>
__device__ __forceinline__ void gemm_phase(PG8_LAS unsigned char* lds, const Gemm g, const Sched& S, const Epi& E, int wave_id) {
    const int wid = wave_id, lane = pg8_lane_id(), tid = wid * 64 + lane, wr = wid >> 2, wc = wid & 3, fr = lane & 15, fq = lane >> 4;
    const int K = g.K, nt = K / BK;
    unsigned voffA[2], voffB[2];
#pragma unroll
    for (int i = 0; i < 2; ++i) { int R, C; stage_rc(tid * 16 + i * 8192, R, C); const int Rb = Epi::PERM ? ((R & ~31) + perm32(R & 31)) : R;
        voffA[i] = (unsigned)(R * K + C) * 2u; voffB[i] = (unsigned)(Rb * K + C) * 2u; }
    const size_t kstep = (size_t)(BK * 2);
    const size_t hstep = (size_t)HALF * K * 2;
    const size_t tstep = 2 * hstep;
    const unsigned ldsw = (unsigned)wid * 1024u;
    const int aoff = lds_byte(wr * 64 + fr, fq * 8), boff = lds_byte(wc * 32 + fr, fq * 8);
#define PG8_SA(b, h) (((b) * 2 + (h)) * HTB)
#define PG8_SB(b, h) ((4 + (b) * 2 + (h)) * HTB)
#define PG8_STAGE(bufoff, gbase, voff) do { _Pragma("unroll") for (int _i = 0; _i < 2; ++_i) \
        __builtin_amdgcn_global_load_lds((const unsigned*)((const char*)(gbase) + (voff)[_i]), (PG8_LAS unsigned*)(lds + (bufoff) + ldsw + _i * 8192), 16, 0, 0); } while (0)
#define PG8_LDA(dst, b, h) do { _Pragma("unroll") for (int m = 0; m < 4; ++m) _Pragma("unroll") for (int k = 0; k < 2; ++k) dst[m][k] = *(const PG8_LAS bf16x8*)(lds + PG8_SA(b, h) + aoff + m * 2048 + k * 1024); } while (0)
#define PG8_LDB(dst, b, h) do { _Pragma("unroll") for (int n = 0; n < 2; ++n) _Pragma("unroll") for (int k = 0; k < 2; ++k) dst[n][k] = *(const PG8_LAS bf16x8*)(lds + PG8_SB(b, h) + boff + n * 2048 + k * 1024); } while (0)
#define PG8_MMA(ai, bj, At, Bt) do { __builtin_amdgcn_s_setprio(1); _Pragma("unroll") for (int m = 0; m < 4; ++m) _Pragma("unroll") for (int n = 0; n < 2; ++n) _Pragma("unroll") for (int k = 0; k < 2; ++k) \
        acc[ai][bj][m][n] = __builtin_amdgcn_mfma_f32_16x16x32_bf16(Bt[n][k], At[m][k], acc[ai][bj][m][n], 0, 0, 0); __builtin_amdgcn_s_setprio(0); } while (0)
#define PG8_WAIT_V(n) asm volatile("s_waitcnt vmcnt(" #n ")" ::: "memory")
#define PG8_WAIT_L(n) asm volatile("s_waitcnt lgkmcnt(" #n ")" ::: "memory")
#define PG8_BAR __builtin_amdgcn_s_barrier()
#define PG8_SCHED __builtin_amdgcn_sched_barrier(0)
    Unit cur, nxt; int ui = 0;
    if (!S.next(0, cur)) return;
    f32x4 acc[2][2][4][2];
#pragma unroll
    for (int a = 0; a < 2; ++a)
#pragma unroll
        for (int b = 0; b < 2; ++b)
#pragma unroll
            for (int m = 0; m < 4; ++m)
#pragma unroll
                for (int n = 0; n < 2; ++n) acc[a][b][m][n] = (f32x4){0.f, 0.f, 0.f, 0.f};
    bf16x8 At[4][2], B0[2][2], B1[2][2];
    const char* cA = (const char*)g.A + (size_t)cur.pm * tstep; const char* cB = (const char*)g.Bt + (size_t)cur.pn * tstep;
    S.a_ready(cur);
    if constexpr (SP2) {
        PG8_STAGE(PG8_SB(0, 0), cB, voffB); PG8_STAGE(PG8_SB(0, 1), cB + hstep, voffB); PG8_STAGE(PG8_SA(0, 0), cA, voffA); PG8_STAGE(PG8_SA(0, 1), cA + hstep, voffA);
        if (wr == 1) PG8_BAR;
        PG8_WAIT_V(2); PG8_BAR;
        PG8_STAGE(PG8_SB(1, 0), cB + kstep, voffB); PG8_STAGE(PG8_SA(1, 0), cA + kstep, voffA); PG8_STAGE(PG8_SB(1, 1), cB + hstep + kstep, voffB);
        PG8_WAIT_V(6); PG8_BAR;
    } else {
        PG8_STAGE(PG8_SB(0, 0), cB, voffB); PG8_STAGE(PG8_SA(0, 0), cA, voffA); PG8_STAGE(PG8_SB(0, 1), cB + hstep, voffB); PG8_STAGE(PG8_SA(0, 1), cA + hstep, voffA);
        if (wr == 1) PG8_BAR;
        PG8_WAIT_V(4); PG8_BAR;
        PG8_STAGE(PG8_SB(1, 0), cB + kstep, voffB); PG8_STAGE(PG8_SA(1, 0), cA + kstep, voffA); PG8_STAGE(PG8_SB(1, 1), cB + hstep + kstep, voffB);
        PG8_WAIT_V(6); PG8_BAR;
    }
    for (;;) {
        const bool has_next = S.next(ui + 1, nxt);
        const char* nA = has_next ? (const char*)g.A + (size_t)nxt.pm * tstep : cA; const char* nB = has_next ? (const char*)g.Bt + (size_t)nxt.pn * tstep : cB;
        for (int t = 0; t < nt; t += 2) {
            const bool last = (t == nt - 2);
            const char* a1 = cA + (size_t)(t + 1) * kstep;
            const char* a2 = last ? nA : cA + (size_t)(t + 2) * kstep; const char* b2 = last ? nB : cB + (size_t)(t + 2) * kstep;
            const char* a3 = a2 + kstep; const char* b3 = b2 + kstep;
            if (last && has_next) S.a_ready(nxt);
            if constexpr (SP2) {
            PG8_LDB(B0, 0, 0); PG8_LDB(B1, 0, 1); PG8_SCHED; PG8_LDA(At, 0, 0); PG8_STAGE(PG8_SA(1, 1), a1 + hstep, voffA);
            PG8_WAIT_V(8); PG8_WAIT_L(0); PG8_BAR; PG8_MMA(0, 0, At, B0); PG8_MMA(0, 1, At, B1); PG8_BAR; PG8_SCHED;
            PG8_LDA(At, 0, 1); PG8_STAGE(PG8_SB(0, 0), b2, voffB); PG8_STAGE(PG8_SB(0, 1), b2 + hstep, voffB); PG8_STAGE(PG8_SA(0, 0), a2, voffA);
            PG8_WAIT_V(8); PG8_WAIT_L(0); PG8_BAR; PG8_MMA(1, 0, At, B0); PG8_MMA(1, 1, At, B1); PG8_BAR; PG8_SCHED;
            PG8_LDB(B0, 1, 0); PG8_LDB(B1, 1, 1); PG8_SCHED; PG8_LDA(At, 1, 0); PG8_STAGE(PG8_SA(0, 1), a2 + hstep, voffA);
            PG8_WAIT_V(8); PG8_WAIT_L(0); PG8_BAR; PG8_MMA(0, 0, At, B0); PG8_MMA(0, 1, At, B1); PG8_BAR; PG8_SCHED;
            PG8_LDA(At, 1, 1); PG8_STAGE(PG8_SB(1, 0), b3, voffB); PG8_STAGE(PG8_SB(1, 1), b3 + hstep, voffB); PG8_STAGE(PG8_SA(1, 0), a3, voffA);
            PG8_WAIT_V(8); PG8_WAIT_L(0); PG8_BAR; PG8_MMA(1, 0, At, B0); PG8_MMA(1, 1, At, B1); PG8_BAR; PG8_SCHED;
            } else {
            PG8_LDB(B0, 0, 0); PG8_SCHED; PG8_LDA(At, 0, 0); PG8_STAGE(PG8_SA(1, 1), a1 + hstep, voffA);
            PG8_WAIT_L(8); PG8_BAR; PG8_WAIT_L(0); PG8_MMA(0, 0, At, B0); PG8_BAR; PG8_SCHED;
            PG8_LDB(B1, 0, 1); PG8_STAGE(PG8_SB(0, 0), b2, voffB);
            PG8_BAR; PG8_WAIT_L(0); PG8_MMA(0, 1, At, B1); PG8_BAR;
            PG8_LDA(At, 0, 1); PG8_STAGE(PG8_SA(0, 0), a2, voffA);
            PG8_BAR; PG8_WAIT_L(0); PG8_MMA(1, 0, At, B0); PG8_BAR; PG8_SCHED;
            PG8_STAGE(PG8_SB(0, 1), b2 + hstep, voffB);
            PG8_WAIT_V(6); PG8_BAR; PG8_MMA(1, 1, At, B1); PG8_BAR;
            PG8_LDB(B0, 1, 0); PG8_SCHED; PG8_LDA(At, 1, 0); PG8_STAGE(PG8_SA(0, 1), a2 + hstep, voffA);
            PG8_WAIT_L(8); PG8_BAR; PG8_WAIT_L(0); PG8_MMA(0, 0, At, B0); PG8_BAR; PG8_SCHED;
            PG8_LDB(B1, 1, 1); PG8_STAGE(PG8_SB(1, 0), b3, voffB);
            PG8_BAR; PG8_WAIT_L(0); PG8_MMA(0, 1, At, B1); PG8_BAR;
            PG8_LDA(At, 1, 1); PG8_STAGE(PG8_SA(1, 0), a3, voffA);
            PG8_BAR; PG8_WAIT_L(0); PG8_MMA(1, 0, At, B0); PG8_BAR; PG8_SCHED;
            PG8_STAGE(PG8_SB(1, 1), b3 + hstep, voffB);
            PG8_WAIT_V(6); PG8_BAR; PG8_MMA(1, 1, At, B1); PG8_BAR;
            }
        }
        if constexpr (ALIGN_EPI) { if (wr == 0) PG8_BAR; }
        if constexpr (!Epi::AFTER_DRAIN) { E(acc, cur, wr, wc, fr, fq); S.done(cur); }
        if (!has_next) break;
#pragma unroll
        for (int a = 0; a < 2; ++a)
#pragma unroll
            for (int b = 0; b < 2; ++b)
#pragma unroll
                for (int m = 0; m < 4; ++m)
#pragma unroll
                    for (int n = 0; n < 2; ++n) acc[a][b][m][n] = (f32x4){0.f, 0.f, 0.f, 0.f};
        cur = nxt; cA = nA; cB = nB; ++ui;
        if constexpr (ALIGN_EPI) { if (wr == 1) PG8_BAR; }
    }
    PG8_WAIT_V(0);
    if constexpr (!ALIGN_EPI) { if (wr == 0) PG8_BAR; }
    PG8_BAR;
    if constexpr (Epi::AFTER_DRAIN) { E.fused(acc, cur, wr, wc, fr, fq, lds, wid, lane); S.done(cur); }
#undef PG8_SA
#undef PG8_SB
#undef PG8_STAGE
#undef PG8_LDA
#undef PG8_LDB
#undef PG8_MMA
#undef PG8_WAIT_V
#undef PG8_WAIT_L
#undef PG8_BAR
#undef PG8_SCHED
}
}
#define PG8_ALIGN true
#ifndef R_SYNC
#define R_SYNC 0
#endif
#ifndef R_HGS
#define R_HGS 1
#endif
#ifndef R_P0
#define R_P0 1
#endif
#ifndef R_G1
#define R_G1 1
#endif
#ifndef R_HG
#define R_HG 1
#endif
#ifndef R_G3
#define R_G3 1
#endif
#ifndef R_G45
#define R_G45 1
#endif
#ifndef R_AT
#define R_AT 1
#endif
#define PG8_SP2 true
#define LAS __attribute__((address_space(3)))
typedef unsigned short bf16_t;
typedef float f32x4 __attribute__((ext_vector_type(4)));
typedef unsigned u32x4 __attribute__((ext_vector_type(4)));
typedef unsigned u32x2 __attribute__((ext_vector_type(2)));
using pg8::cvt_pk_bf16;
constexpr int NTOK = 8192, DM = 2048, SEQ = 2048, DI = 4096;
constexpr float EPS = 1e-6f;
constexpr size_t MiB = 1u << 20;
constexpr size_t WS_W2T = 1 * MiB, WS_W3T = 17 * MiB, WS_W4T = 39 * MiB, WS_W5T = 48 * MiB, WS_W6T = 56 * MiB;
constexpr size_t WS_QH = 72 * MiB, WS_VI = 104 * MiB, WS_GS = 168 * MiB, WS_ST = 232 * MiB, WS_W1T = 232 * MiB, WS_XN = 280 * MiB;
constexpr size_t WS_H1B = 72 * MiB, WS_Q = 72 * MiB, WS_KN = 168 * MiB, WS_GATE = 232 * MiB, WS_CQ = 296 * MiB, WS_C = 308 * MiB, WS_KR = 316 * MiB, WS_V = 317 * MiB;
constexpr size_t WS_SS1 = 381 * MiB, WS_SSQ = 382 * MiB, WS_SSC = 382 * MiB + 512 * 1024, WS_SS2 = 383 * MiB, WS_NEED = 384 * MiB;
constexpr int LDS_BYTES = 147456;
constexpr float QSCALE = 0.07216878364870322f * 1.4426950408889634f;

#define XB_TMO      128
#define XB_XCNT(j)  (256  + 64 * (j))
#define XB_XSUB(j)  (1280 + 64 * (j))
#define XB_XGEN(j)  (2304 + 64 * (j))
#define XB_TOP      3328
#define XB_TOPGEN   3392
#define XCD_BAR_WORDS 3456
#define XB_SPIN_CAP (1u << 18)

__device__ __forceinline__ unsigned xb_ld(unsigned* p)              { return __hip_atomic_load(p, __ATOMIC_RELAXED, __HIP_MEMORY_SCOPE_AGENT); }
__device__ __forceinline__ unsigned xb_add(unsigned* p, unsigned v) { return __hip_atomic_fetch_add(p, v, __ATOMIC_RELAXED, __HIP_MEMORY_SCOPE_AGENT); }
__device__ __forceinline__ unsigned xb_xcc_id() { return (unsigned)__builtin_amdgcn_s_getreg((3 << 11) | 20) & 0xFu; }
#define XB_SPIN(cond, bar) do { unsigned _sp = 0; while (cond) { __builtin_amdgcn_s_sleep(1); \
    if ((++_sp & 255u) == 0u) { if (xb_ld(&(bar)[XB_TMO])) break; if (_sp > XB_SPIN_CAP) { atomicAdd(&(bar)[XB_TMO], 1u); break; } } } } while (0)

struct XcdBarrier {
    unsigned* bar; unsigned x;
    volatile LAS unsigned* st;
};

__device__ __forceinline__ XcdBarrier xcd_barrier_post(unsigned* bar, volatile LAS unsigned* st) {
    XcdBarrier b; b.bar = bar; b.x = xb_xcc_id(); b.st = st;
    if (threadIdx.x == 0) (void)xb_add(&bar[XB_XCNT(b.x)], 1u);
    return b;
}
__device__ __forceinline__ void xcd_barrier_complete(unsigned* bar, unsigned x, unsigned& nloc, unsigned& nx) {
    const unsigned G = gridDim.x * gridDim.y * gridDim.z;
    unsigned sum, cnt, mine, sp = 0u;
    for (;;) {
        sum = 0u; cnt = 0u; mine = 0u;
#pragma unroll
        for (unsigned j = 0; j < 16; ++j) { const unsigned c = xb_ld(&bar[XB_XCNT(j)]); sum += c; cnt += (c > 0u) ? 1u : 0u; mine = (j == x) ? c : mine; }
        if (sum == G) break;
        __builtin_amdgcn_s_sleep(1);
        if ((++sp & 255u) == 0u) { if (xb_ld(&bar[XB_TMO])) break; if (sp > XB_SPIN_CAP) { atomicAdd(&bar[XB_TMO], 1u); break; } }
    }
    nloc = mine > 0u ? mine : 1u; nx = cnt > 0u ? cnt : 1u;
}

__device__ __forceinline__ void xcd_barrier(const XcdBarrier& b) {
    asm volatile("s_waitcnt vmcnt(0)" ::: "memory");
    __syncthreads();
    if (threadIdx.x == 0) {
        unsigned* bar = b.bar;
        __builtin_amdgcn_s_waitcnt(0);
        unsigned nloc = b.st[0], nx = b.st[1];
        if (nloc == 0u) { xcd_barrier_complete(bar, b.x, nloc, nx); b.st[0] = nloc; b.st[1] = nx; }
        const unsigned old = xb_add(&bar[XB_XSUB(b.x)], 1u);
        const unsigned gen = old / nloc;
        if (old + 1u == (gen + 1u) * nloc) {
            __builtin_amdgcn_fence(__ATOMIC_RELEASE, "agent");
            asm volatile("s_waitcnt vmcnt(0)" ::: "memory");
            const unsigned og = xb_add(&bar[XB_TOP], 1u);
            const unsigned tg = og / nx;
            if (og + 1u == (tg + 1u) * nx) xb_add(&bar[XB_TOPGEN], 1u);
            else XB_SPIN(xb_ld(&bar[XB_TOPGEN]) == tg, bar);
            __builtin_amdgcn_fence(__ATOMIC_ACQUIRE, "agent");
            xb_add(&bar[XB_XGEN(b.x)], 1u);
            asm volatile("s_waitcnt vmcnt(0)" ::: "memory");
        } else {
            XB_SPIN(xb_ld(&bar[XB_XGEN(b.x)]) == gen, bar);
            __builtin_amdgcn_fence(__ATOMIC_ACQUIRE, "agent");
            asm volatile("s_waitcnt vmcnt(0)" ::: "memory");
        }
    }
    __syncthreads();
}

struct Params {
    const float* x; const float* norm_g; const float* hg_w_in; const float* hg_g_norm; const float* hg_w_out; const float* hg_lb;
    const float* kv_in_norm_g; const float* w_kv_down; const float* kv_norm_g; const float* w_kv_up; const float* mla_w_in; const float* mla_q_norm_g;
    const float* mla_w_q_up; const float* mla_w_out; const float* final_norm_g;
    float* out; unsigned char* ws;
};

__device__ __forceinline__ float bf2f(bf16_t v) { return __uint_as_float((unsigned)v << 16); }
__device__ __forceinline__ float bflo(unsigned u) { return __uint_as_float(u << 16); }
__device__ __forceinline__ float bfhi(unsigned u) { return __uint_as_float(u & 0xffff0000u); }
__device__ __forceinline__ float silu_f(float v) { return v * __builtin_amdgcn_rcpf(1.0f + __builtin_amdgcn_exp2f(-1.4426950408889634f * v)); }
__device__ __forceinline__ float wave_sum(float v) {
#pragma unroll
    for (int o = 1; o < 64; o <<= 1) v += __shfl_xor(v, o);
    return v;
}
__device__ __forceinline__ void store8_bf16(bf16_t* p, const f32x4& a, const f32x4& b) {
    u32x4 w; w.x = cvt_pk_bf16(a[0], a[1]); w.y = cvt_pk_bf16(a[2], a[3]); w.z = cvt_pk_bf16(b[0], b[1]); w.w = cvt_pk_bf16(b[2], b[3]);
    *(u32x4*)p = w;
}
__device__ __forceinline__ void rope8(f32x4& a, f32x4& b, int pos, int j0) {
    float v[8] = {a[0], a[1], a[2], a[3], b[0], b[1], b[2], b[3]};
#pragma unroll
    for (int p = 0; p < 4; ++p) {
        const float inv = __builtin_amdgcn_exp2f(-(float)(j0 + p) * 0.41524101186092029f);
        float rev = (float)pos * inv * 0.15915494309189535f; rev = rev - floorf(rev);
        const float c = __builtin_amdgcn_cosf(rev), s = __builtin_amdgcn_sinf(rev);
        const float x1 = v[2 * p], x2 = v[2 * p + 1];
        v[2 * p] = x1 * c - x2 * s; v[2 * p + 1] = x2 * c + x1 * s;
    }
    a = (f32x4){v[0], v[1], v[2], v[3]}; b = (f32x4){v[4], v[5], v[6], v[7]};
}

typedef const f32x4 (&AccRef)[2][2][4][2];
struct EpiG1 {
    static constexpr bool PERM = true, AFTER_DRAIN = false;
    bf16_t* Qh; float* F; bf16_t* VI; bf16_t* GS;
    __device__ __forceinline__ void operator()(AccRef acc, const pg8::Unit& u, int wr, int wc, int fr, int fq) const {
        const int pn = u.pn;
#pragma unroll
        for (int ai = 0; ai < 2; ++ai)
#pragma unroll
            for (int m = 0; m < 4; ++m) {
                const size_t row = (size_t)(u.pm * 256 + ai * 128 + wr * 64 + m * 16 + fr);
#pragma unroll
                for (int bj = 0; bj < 2; ++bj) {
                    const int col = pn * 256 + bj * 128 + wc * 32 + 8 * fq;
                    f32x4 a = acc[ai][bj][m][0], b = acc[ai][bj][m][1];
                    if (pn < 8) store8_bf16(Qh + row * 2048 + col, a, b);
                    else if (pn < 16) { float* o = F + row * 2048 + (col - 2048); *(f32x4*)o = a; *(f32x4*)(o + 4) = b; }
                    else if (pn < 32) store8_bf16(VI + row * 4096 + (col - 4096), a, b);
                    else {
#pragma unroll
                        for (int j = 0; j < 4; ++j) { a[j] = silu_f(a[j]); b[j] = silu_f(b[j]); }
                        store8_bf16(GS + row * 4096 + (col - 8192), a, b);
                    }
                }
            }
    }
};
#ifndef R_EPI
#define R_EPI 1
#endif
template <class E0> struct EpiRep {
    static constexpr bool PERM = E0::PERM, AFTER_DRAIN = false;
    E0 e;
    __device__ __forceinline__ void operator()(AccRef acc, const pg8::Unit& u, int wr, int wc, int fr, int fq) const {
        _Pragma("unroll") for (int r_ = 0; r_ < R_EPI; ++r_) { e(acc, u, wr, wc, fr, fq); asm volatile("" ::: "memory"); }
    }
};
template <bool WB> struct EpiRes {
    static constexpr bool PERM = true, AFTER_DRAIN = false;
    const float* base; float* out; bf16_t* outb; float* ss;
    __device__ __forceinline__ void operator()(AccRef acc, const pg8::Unit& u, int wr, int wc, int fr, int fq) const {
#pragma unroll
        for (int ai = 0; ai < 2; ++ai)
#pragma unroll
            for (int m = 0; m < 4; ++m) {
                const size_t row = (size_t)(u.pm * 256 + ai * 128 + wr * 64 + m * 16 + fr);
                float s = 0.f;
#pragma unroll
                for (int bj = 0; bj < 2; ++bj) {
                    const int col = u.pn * 256 + bj * 128 + wc * 32 + 8 * fq;
                    const size_t off = row * 2048 + col;
                    f32x4 a = acc[ai][bj][m][0] + *(const f32x4*)(base + off), b = acc[ai][bj][m][1] + *(const f32x4*)(base + off + 4);
                    *(f32x4*)(out + off) = a; *(f32x4*)(out + off + 4) = b;
                    if (WB) store8_bf16(outb + off, a, b);
                    s += (a[0] * a[0] + a[1] * a[1]) + (a[2] * a[2] + a[3] * a[3]) + (b[0] * b[0] + b[1] * b[1]) + (b[2] * b[2] + b[3] * b[3]);
                }
                s += __shfl_xor(s, 16); s += __shfl_xor(s, 32);
                if (fq == 0) ss[row * 32 + u.pn * 4 + wc] = s;
            }
    }
};
struct EpiG3 {
    static constexpr bool PERM = true, AFTER_DRAIN = false;
    const float* ss1; bf16_t* CQ; bf16_t* GATE; bf16_t* C; bf16_t* KR; float* ssq; float* ssc;
    __device__ __forceinline__ void operator()(AccRef acc, const pg8::Unit& u, int wr, int wc, int fr, int fq) const {
        const int pn = u.pn;
#pragma unroll
        for (int ai = 0; ai < 2; ++ai)
#pragma unroll
            for (int m = 0; m < 4; ++m) {
                const size_t row = (size_t)(u.pm * 256 + ai * 128 + wr * 64 + m * 16 + fr);
                float t = 0.f;
                { const f32x4* sp = (const f32x4*)(ss1 + row * 32);
#pragma unroll
                  for (int i = 0; i < 8; ++i) { const f32x4 q = sp[i]; t += (q[0] + q[1]) + (q[2] + q[3]); } }
                const float rs = __builtin_amdgcn_rsqf(t * (1.0f / 2048.0f) + EPS);
                float s = 0.f;
#pragma unroll
                for (int bj = 0; bj < 2; ++bj) {
                    const int lc = bj * 128 + wc * 32 + 8 * fq;
                    f32x4 a = acc[ai][bj][m][0] * rs, b = acc[ai][bj][m][1] * rs;
                    if (pn < 3) { store8_bf16(CQ + row * 768 + pn * 256 + lc, a, b); }
                    else if (pn < 19) {
#pragma unroll
                        for (int j = 0; j < 4; ++j) { a[j] = silu_f(a[j]); b[j] = silu_f(b[j]); }
                        store8_bf16(GATE + row * 4096 + (pn - 3) * 256 + lc, a, b);
                    } else if (pn < 21) { store8_bf16(C + row * 512 + (pn - 19) * 256 + lc, a, b); }
                    else if (bj == 0 && wc < 2) { rope8(a, b, (int)(row & 2047), wc * 16 + 4 * fq); store8_bf16(KR + row * 64 + lc, a, b); }
                    s += (a[0] * a[0] + a[1] * a[1]) + (a[2] * a[2] + a[3] * a[3]) + (b[0] * b[0] + b[1] * b[1]) + (b[2] * b[2] + b[3] * b[3]);
                }
                s += __shfl_xor(s, 16); s += __shfl_xor(s, 32);
                if (fq == 0) { if (pn < 3) ssq[row * 16 + pn * 4 + wc] = s; else if (pn == 19 || pn == 20) ssc[row * 8 + (pn - 19) * 4 + wc] = s; }
            }
    }
};
struct EpiQ {
    static constexpr bool PERM = true, AFTER_DRAIN = false;
    const float* ssq; bf16_t* Q;
    __device__ __forceinline__ void operator()(AccRef acc, const pg8::Unit& u, int wr, int wc, int fr, int fq) const {
        const int pn = u.pn;
#pragma unroll
        for (int ai = 0; ai < 2; ++ai)
#pragma unroll
            for (int m = 0; m < 4; ++m) {
                const int row = u.pm * 256 + ai * 128 + wr * 64 + m * 16 + fr;
                const f32x4* sp = (const f32x4*)(ssq + (size_t)row * 16);
                const f32x4 q0 = sp[0], q1 = sp[1], q2 = sp[2];
                const float t = ((q0[0] + q0[1]) + (q0[2] + q0[3])) + ((q1[0] + q1[1]) + (q1[2] + q1[3])) + ((q2[0] + q2[1]) + (q2[2] + q2[3]));
                const float rs = __builtin_amdgcn_rsqf(t * (1.0f / 768.0f) + EPS) * QSCALE;
                const int b_ = row >> 11, s_ = row & 2047;
#pragma unroll
                for (int bj = 0; bj < 2; ++bj) {
                    f32x4 a = acc[ai][bj][m][0] * rs, b = acc[ai][bj][m][1] * rs;
                    if (pn < 16) { const int h = pn * 2 + bj; store8_bf16(Q + ((size_t)((b_ * 32 + h) * 2048 + s_)) * 192 + wc * 32 + 8 * fq, a, b); }
                    else { const int h = (pn - 16) * 4 + bj * 2 + (wc >> 1), off = (wc & 1) * 32 + 8 * fq;
                        rope8(a, b, s_, off >> 1); store8_bf16(Q + ((size_t)((b_ * 32 + h) * 2048 + s_)) * 192 + 128 + off, a, b); }
                }
            }
    }
};
struct EpiKV {
    static constexpr bool PERM = true, AFTER_DRAIN = false;
    const float* ssc; bf16_t* KN; bf16_t* V;
    __device__ __forceinline__ void operator()(AccRef acc, const pg8::Unit& u, int wr, int wc, int fr, int fq) const {
        const int h = u.pn;
#pragma unroll
        for (int ai = 0; ai < 2; ++ai)
#pragma unroll
            for (int m = 0; m < 4; ++m) {
                const int row = u.pm * 256 + ai * 128 + wr * 64 + m * 16 + fr;
                const f32x4* sp = (const f32x4*)(ssc + (size_t)row * 8);
                const f32x4 q0 = sp[0], q1 = sp[1];
                const float t = ((q0[0] + q0[1]) + (q0[2] + q0[3])) + ((q1[0] + q1[1]) + (q1[2] + q1[3]));
                const float rs = __builtin_amdgcn_rsqf(t * (1.0f / 512.0f) + EPS);
                const int b_ = row >> 11, s_ = row & 2047;
                const size_t o = ((size_t)((b_ * 32 + h) * 2048 + s_)) * 128 + wc * 32 + 8 * fq;
                store8_bf16(KN + o, acc[ai][0][m][0] * rs, acc[ai][0][m][1] * rs);
                store8_bf16(V + o, acc[ai][1][m][0] * rs, acc[ai][1][m][1] * rs);
            }
    }
};

template <int MODE> __device__ __forceinline__ int src_col(int n) {
    if (MODE == 0) return n;
    if (MODE == 1) { if (n < 512) return n; const int o = n - 512; return 512 + (o >> 1) + 32 * (o & 1); }
    if (n < 4096) return (n >> 7) * 192 + (n & 127);
    const int r = n - 4096, h = r >> 6, o = r & 63; return h * 192 + 128 + (o >> 1) + 32 * (o & 1);
}
template <int MODE> __device__ __forceinline__ void transpose_item(const float* __restrict__ W, int K, int Nsrc, int Nout, const float* __restrict__ gain, bf16_t* WT, int row_off, LAS float* scr, int item, int lane) {
    const int nblk = Nout / 32, kb = item / nblk, nb = item % nblk, k0 = 64 * kb, n0 = 32 * nb;
    const int sc = src_col<MODE>(n0 + (lane & 31));
#pragma unroll 8
    for (int i = 0; i < 32; ++i) { const int kk = 2 * i + (lane >> 5); const float g = gain ? gain[k0 + kk] : 1.0f; scr[kk * 33 + (lane & 31)] = W[(size_t)(k0 + kk) * Nsrc + sc] * g; }
    asm volatile("s_waitcnt lgkmcnt(0)" ::: "memory");
    const int c = lane & 7;
#pragma unroll
    for (int j = 0; j < 4; ++j) { const int n = (lane >> 3) + 8 * j; const LAS float* s = scr + (8 * c) * 33 + n;
        u32x4 o; o.x = cvt_pk_bf16(s[0 * 33], s[1 * 33]); o.y = cvt_pk_bf16(s[2 * 33], s[3 * 33]); o.z = cvt_pk_bf16(s[4 * 33], s[5 * 33]); o.w = cvt_pk_bf16(s[6 * 33], s[7 * 33]);
        *(u32x4*)(WT + (size_t)(row_off + n0 + n) * K + k0 + 8 * c) = o; }
    asm volatile("s_waitcnt lgkmcnt(0)" ::: "memory");
}
__device__ __forceinline__ void transpose_item64(const float* __restrict__ W, int K, int N, const float* __restrict__ gain, bf16_t* WT, int row_off, LAS float* scr, int item, int lane) {
    const int nblk = N / 64, kb = item / nblk, nb = item % nblk, k0 = 64 * kb, n0 = 64 * nb;
    const int lr = lane >> 4, lc = (lane & 15) * 4;
    f32x4 v[16];
#pragma unroll
    for (int i = 0; i < 16; ++i) v[i] = *(const f32x4*)(W + (size_t)(k0 + 4 * i + lr) * N + n0 + lc);
#pragma unroll
    for (int i = 0; i < 16; ++i) { const int kk = 4 * i + lr; const float g = gain ? gain[k0 + kk] : 1.0f; LAS float* d = scr + kk * 65 + lc;
        d[0] = v[i][0] * g; d[1] = v[i][1] * g; d[2] = v[i][2] * g; d[3] = v[i][3] * g; }
    asm volatile("s_waitcnt lgkmcnt(0)" ::: "memory");
    const int c = lane & 7;
#pragma unroll
    for (int j = 0; j < 8; ++j) { const int n = (lane >> 3) + 8 * j; const LAS float* s = scr + (8 * c) * 65 + n;
        u32x4 o; o.x = cvt_pk_bf16(s[0 * 65], s[1 * 65]); o.y = cvt_pk_bf16(s[2 * 65], s[3 * 65]); o.z = cvt_pk_bf16(s[4 * 65], s[5 * 65]); o.w = cvt_pk_bf16(s[6 * 65], s[7 * 65]);
        *(u32x4*)(WT + (size_t)(row_off + n0 + n) * K + k0 + 8 * c) = o; }
    asm volatile("s_waitcnt lgkmcnt(0)" ::: "memory");
}
__device__ __forceinline__ void phase0(const Params& p, LAS unsigned char* lds, int wave, int lane, int gw, int NGW) {
    LAS float* scr = (LAS float*)(lds + wave * 16640);
    bf16_t* W1T = (bf16_t*)(p.ws + WS_W1T); bf16_t* W2T = (bf16_t*)(p.ws + WS_W2T); bf16_t* W3T = (bf16_t*)(p.ws + WS_W3T);
    bf16_t* W4T = (bf16_t*)(p.ws + WS_W4T); bf16_t* W5T = (bf16_t*)(p.ws + WS_W5T); bf16_t* W6T = (bf16_t*)(p.ws + WS_W6T);
    constexpr int I1 = 32 * 192, I2 = 64 * 32, I3a = 32 * 76, I3b = 32 * 18, I4 = 12 * 192, I5 = 8 * 128, I6 = 64 * 32;
    constexpr int NIT = I1 + I2 + I3a + I3b + I4 + I5 + I6;
    for (int it = gw; it < NIT; it += NGW) {
        int r = it;
        if (r < I1) { transpose_item64(p.hg_w_in, 2048, 12288, p.norm_g, W1T, 0, scr, r, lane); continue; } r -= I1;
        if (r < I2) { transpose_item64(p.hg_w_out, 4096, 2048, nullptr, W2T, 0, scr, r, lane); continue; } r -= I2;
        if (r < I3a) { transpose_item64(p.mla_w_in, 2048, 4864, p.norm_g + 2048, W3T, 0, scr, r, lane); continue; } r -= I3a;
        if (r < I3b) { transpose_item<1>(p.w_kv_down, 2048, 576, 576, p.kv_in_norm_g, W3T, 4864, scr, r, lane); continue; } r -= I3b;
        if (r < I4) { transpose_item<2>(p.mla_w_q_up, 768, 6144, 6144, p.mla_q_norm_g, W4T, 0, scr, r, lane); continue; } r -= I4;
        if (r < I5) { transpose_item64(p.w_kv_up, 512, 8192, p.kv_norm_g, W5T, 0, scr, r, lane); continue; } r -= I5;
        transpose_item64(p.mla_w_out, 4096, 2048, nullptr, W6T, 0, scr, r, lane);
    }
    {
        u32x4* z = (u32x4*)(W3T + (size_t)5440 * 2048);
        for (int i = gw * 64 + lane; i < 192 * 2048 / 8; i += NGW * 64) z[i] = (u32x4){0u, 0u, 0u, 0u};
    }
    bf16_t* XN = (bf16_t*)(p.ws + WS_XN);
    for (int m = gw; m < NTOK; m += NGW) {
        const f32x4* xr = (const f32x4*)(p.x + (size_t)m * 2048) + lane;
        f32x4 v[8]; float s = 0.f;
#pragma unroll
        for (int j = 0; j < 8; ++j) { v[j] = xr[64 * j]; s += (v[j][0] * v[j][0] + v[j][1] * v[j][1]) + (v[j][2] * v[j][2] + v[j][3] * v[j][3]); }
        const float rs = __builtin_amdgcn_rsqf(wave_sum(s) * (1.0f / 2048.0f) + EPS);
        u32x2* o8 = (u32x2*)(XN + (size_t)m * 2048) + lane;
#pragma unroll
        for (int j = 0; j < 8; ++j) { u32x2 w; w.x = cvt_pk_bf16(v[j][0] * rs, v[j][1] * rs); w.y = cvt_pk_bf16(v[j][2] * rs, v[j][3] * rs); o8[64 * j] = w; }
    }
}

__device__ __forceinline__ void hgrn_naive(const Params& p, LAS unsigned char* lds, int tid) {
    if (blockIdx.x >= 64) return;
    const int bh = blockIdx.x, b = bh >> 4, h = bh & 15;
    LAS float* fg = (LAS float*)lds; LAS float* kks = fg + 128; LAS float* qs = kks + 128; LAS float* op = qs + 128; LAS float* red = op + 512;
    const float* F = p.out; const bf16_t* Qh = (const bf16_t*)(p.ws + WS_QH); const bf16_t* VI = (const bf16_t*)(p.ws + WS_VI); bf16_t* GS = (bf16_t*)(p.ws + WS_GS);
    const int v = tid & 255, half = tid >> 8, wave = tid >> 6, lane = tid & 63;
    float S[64];
#pragma unroll
    for (int j = 0; j < 64; ++j) S[j] = 0.f;
    float lb = 0.f;
    if (tid < 128) { const float a = p.hg_lb[h * 128 + tid], bb = p.hg_lb[2048 + h * 128 + tid]; lb = 1.0f / (1.0f + __expf(bb - a)); }
    const float gn = p.hg_g_norm[v];
    for (int t = 0; t < SEQ; ++t) {
        const size_t row = (size_t)b * SEQ + t;
        if (tid < 128) {
            const float f = F[row * 2048 + h * 128 + tid]; const float q = bf2f(Qh[row * 2048 + h * 128 + tid]);
            const float sg = 1.0f / (1.0f + __expf(-f));
            fg[tid] = lb + (1.0f - lb) * sg; kks[tid] = (1.0f - lb) * (1.0f - sg); qs[tid] = q;
        }
        const float iv = bf2f(VI[row * 4096 + h * 256 + v]);
        __syncthreads();
        float o = 0.f;
#pragma unroll
        for (int j = 0; j < 64; ++j) { const int k = half * 64 + j; S[j] = fg[k] * S[j] + kks[k] * iv; o += qs[k] * S[j]; }
        op[half * 256 + v] = o;
        __syncthreads();
        const float of = op[v] + op[256 + v];
        const float sq = wave_sum(of * of);
        if (lane == 0) red[wave] = sq;
        __syncthreads();
        const float tot = (red[0] + red[1]) + (red[2] + red[3]);
        const float rs = __builtin_amdgcn_rsqf(tot * (1.0f / 256.0f) + EPS);
        if (half == 0) { bf16_t* g = GS + row * 4096 + h * 256 + v; const float y = of * rs * gn * bf2f(*g); *g = (bf16_t)(cvt_pk_bf16(y, 0.f) & 0xffffu); }
    }
}

typedef short bf16x8 __attribute__((ext_vector_type(8)));
typedef short s16x4 __attribute__((ext_vector_type(4)));
typedef float f32x16 __attribute__((ext_vector_type(16)));
__device__ __forceinline__ s16x4 tr_read(LAS const unsigned char* p) { return __builtin_bit_cast(s16x4, __builtin_amdgcn_ds_read_tr16_b64_v4i16((LAS s16x4*)p)); }
__device__ __forceinline__ bf16_t f2bf(float x) { return (bf16_t)(cvt_pk_bf16(x, 0.f) & 0xffffu); }
#define HG_BAR() do { asm volatile("s_waitcnt vmcnt(0) lgkmcnt(0)" ::: "memory"); __builtin_amdgcn_s_barrier(); asm volatile("" ::: "memory"); } while (0)
#define HG_BAR_L() do { asm volatile("s_waitcnt lgkmcnt(0)" ::: "memory"); __builtin_amdgcn_s_barrier(); asm volatile("" ::: "memory"); } while (0)
__device__ __forceinline__ void hgrn_state_phase(const Params& p, LAS unsigned char* lds, int tid, int wave, int lane) {
    constexpr int SQT = 0, SDEC = 2048, SKD = 4096, SKDROW = 320, SVT = SKD + 64 * SKDROW, SVTROW = 192;
    const float* F = p.out; const bf16_t* VI = (const bf16_t*)(p.ws + WS_VI); bf16_t* ST = (bf16_t*)(p.ws + WS_ST);
    LAS float* QT = (LAS float*)(lds + SQT); LAS float* DEC = (LAS float*)(lds + SDEC);
    const int r32 = lane & 31, hi = lane >> 5, i16 = lane & 15, g1 = (lane >> 4) & 1;
    const int k = tid & 127, tq = tid >> 7;
    for (int unit = blockIdx.x; unit < 256; unit += gridDim.x) {
        const int bh = unit >> 2, vq = unit & 3, b = bh >> 4, h = bh & 15;
        float lb; { const float a = p.hg_lb[h * 128 + k], bb = p.hg_lb[2048 + h * 128 + k]; lb = 1.0f / (1.0f + __expf(bb - a)); }
        const float oml = 1.0f - lb;
        const float* Fp = F + ((size_t)(b * 2048 + 16 * tq)) * 2048 + h * 128 + k;
        const bf16_t* Vp = VI + ((size_t)(b * 2048 + (tid >> 3))) * 4096 + h * 256 + vq * 64 + (tid & 7) * 8;
        f32x16 acc;
#pragma unroll
        for (int r = 0; r < 16; ++r) acc[r] = 0.f;
        float fr[16]; u32x4 vr;
#pragma unroll
        for (int i = 0; i < 16; ++i) fr[i] = Fp[(size_t)i * 2048];
        vr = *(const u32x4*)Vp;
        const int vi = wave & 1, ki = wave >> 1;
        for (int c = 0; c < 32; ++c) {
            float cs[16], kk[16]; float run = 0.f;
#pragma unroll
            for (int i = 0; i < 16; ++i) {
                const float e = __builtin_amdgcn_exp2f(-1.4426950408889634f * fr[i]); const float sg = __builtin_amdgcn_rcpf(1.0f + e);
                run += __builtin_amdgcn_logf(lb + oml * sg); cs[i] = run; kk[i] = oml * e * sg;
            }
            QT[tq * 128 + k] = run;
            HG_BAR_L();
            const float q0 = QT[k], q1 = QT[128 + k], q2 = QT[256 + k], q3 = QT[384 + k];
            const float off = (tq > 0 ? q0 : 0.f) + (tq > 1 ? q1 : 0.f) + (tq > 2 ? q2 : 0.f), bl = (q0 + q1) + (q2 + q3);
#pragma unroll
            for (int i = 0; i < 16; ++i) *(LAS bf16_t*)(lds + SKD + (16 * tq + i) * SKDROW + k * 2) = f2bf(kk[i] * __builtin_amdgcn_exp2f(bl - (off + cs[i])));
            if (tq == 0) DEC[k] = __builtin_amdgcn_exp2f(bl);
            *(LAS u32x4*)(lds + SVT + (tid >> 3) * SVTROW + (tid & 7) * 16) = vr;
            if (c + 1 < 32) {
                const float* Fn = Fp + (size_t)(c + 1) * 64 * 2048;
#pragma unroll
                for (int i = 0; i < 16; ++i) fr[i] = Fn[(size_t)i * 2048];
                vr = *(const u32x4*)(Vp + (size_t)(c + 1) * 64 * 4096);
            }
            HG_BAR_L();
            {
                bf16_t* sp = ST + ((size_t)((bh * 32 + c) * 256 + vq * 64 + 32 * vi)) * 128 + 32 * ki + r32;
#pragma unroll
                for (int r = 0; r < 16; ++r) sp[(size_t)((r & 3) + 8 * (r >> 2) + 4 * hi) * 128] = f2bf(acc[r]);
                const float dc = DEC[32 * ki + r32];
#pragma unroll
                for (int r = 0; r < 16; ++r) acc[r] *= dc;
                LAS const unsigned char* va = lds + SVT + (8 * hi + (i16 >> 2)) * SVTROW + (32 * vi + 16 * g1 + 4 * (i16 & 3)) * 2;
                LAS const unsigned char* ka = lds + SKD + (8 * hi + (i16 >> 2)) * SKDROW + (32 * ki + 16 * g1 + 4 * (i16 & 3)) * 2;
#pragma unroll
                for (int st = 0; st < 4; ++st) {
                    const s16x4 a0 = tr_read(va + st * 16 * SVTROW), a1 = tr_read(va + st * 16 * SVTROW + 4 * SVTROW);
                    const s16x4 b0 = tr_read(ka + st * 16 * SKDROW), b1 = tr_read(ka + st * 16 * SKDROW + 4 * SKDROW);
                    const bf16x8 af = (bf16x8){a0[0], a0[1], a0[2], a0[3], a1[0], a1[1], a1[2], a1[3]};
                    const bf16x8 bf = (bf16x8){b0[0], b0[1], b0[2], b0[3], b1[0], b1[1], b1[2], b1[3]};
                    acc = __builtin_amdgcn_mfma_f32_32x32x16_bf16(af, bf, acc, 0, 0, 0);
                }
            }
        }
        HG_BAR_L();
    }
}
__device__ __forceinline__ void hgrn_out_phase(const Params& p, LAS unsigned char* lds, int tid, int wave, int lane, int do_store) {
    constexpr int QROW = 272, OQD = 0, OQM = 17408, OKM = 34816, OQO = 52224, OKO = 60928, OVT = 69632, VROW = 576, OPS = 106496, PROW = 144, OQT = 115712, OROW = 1040;
    typedef float f32x2 __attribute__((ext_vector_type(2)));
    const float* F = p.out; const bf16_t* Qh = (const bf16_t*)(p.ws + WS_QH); const bf16_t* VI = (const bf16_t*)(p.ws + WS_VI); const bf16_t* ST = (const bf16_t*)(p.ws + WS_ST); bf16_t* GS = (bf16_t*)(p.ws + WS_GS);
    LAS float* QT = (LAS float*)(lds + OQT);
    const int r32 = lane & 31, hi = lane >> 5, i16 = lane & 15, g1 = (lane >> 4) & 1;
    const int k2 = lane, tg = wave, th = tg >> 2;
    f32x2 fr[8]; unsigned qv[8]; u32x4 vr[4]; bf16x8 sfr[8]; u32x4 gsr[4];
    f32x4 gnr[8];
    { const f32x4* gn_ = (const f32x4*)(p.hg_g_norm + (tid & 7) * 32);
#pragma unroll
      for (int j = 0; j < 8; ++j) gnr[j] = gn_[j]; }
#define HO_LOAD_FQ(u_) do { const int bh_ = (u_) >> 5, c_ = (u_) & 31, b_ = bh_ >> 4, h_ = bh_ & 15; const size_t ro_ = (size_t)(b_ * 2048 + c_ * 64 + 8 * tg) * 2048 + h_ * 128 + 2 * k2; \
        _Pragma("unroll") for (int i = 0; i < 8; ++i) { fr[i] = *(const f32x2*)(F + ro_ + (size_t)i * 2048); qv[i] = *(const unsigned*)(Qh + ro_ + (size_t)i * 2048); } } while (0)
#define HO_LOAD_V(u_) do { const int bh_ = (u_) >> 5, c_ = (u_) & 31, b_ = bh_ >> 4, h_ = bh_ & 15; \
        _Pragma("unroll") for (int j = 0; j < 4; ++j) { const int id = tid + 512 * j; vr[j] = *(const u32x4*)(VI + ((size_t)(b_ * 2048 + c_ * 64 + (id >> 5))) * 4096 + h_ * 256 + (id & 31) * 8); } } while (0)
#define HO_LOAD_S(u_) do { const bf16_t* sp_ = ST + ((size_t)((u_) * 256 + 32 * wave + r32)) * 128 + 8 * hi; \
        _Pragma("unroll") for (int s_ = 0; s_ < 8; ++s_) sfr[s_] = *(const bf16x8*)(sp_ + 16 * s_); } while (0)
    int unit = blockIdx.x;
    if (unit < 2048) { HO_LOAD_FQ(unit); HO_LOAD_V(unit); HO_LOAD_S(unit); }
    for (; unit < 2048; unit += gridDim.x) {
        const int bh = unit >> 5, c = unit & 31, b = bh >> 4, h = bh & 15, row0 = b * 2048 + c * 64;
        const int nxt = unit + gridDim.x;
        float lb0, lb1; { const f32x2 a = *(const f32x2*)(p.hg_lb + h * 128 + 2 * k2), bb = *(const f32x2*)(p.hg_lb + 2048 + h * 128 + 2 * k2);
            lb0 = 1.0f / (1.0f + __expf(bb[0] - a[0])); lb1 = 1.0f / (1.0f + __expf(bb[1] - a[1])); }
        const float om0 = 1.0f - lb0, om1 = 1.0f - lb1;
        float cs0[8], cs1[8], kk0[8], kk1[8]; float run0 = 0.f, run1 = 0.f;
#pragma unroll
        for (int i = 0; i < 8; ++i) {
            const float e0 = __builtin_amdgcn_exp2f(-1.4426950408889634f * fr[i][0]), e1 = __builtin_amdgcn_exp2f(-1.4426950408889634f * fr[i][1]);
            const float s0 = __builtin_amdgcn_rcpf(1.0f + e0), s1 = __builtin_amdgcn_rcpf(1.0f + e1);
            run0 += __builtin_amdgcn_logf(lb0 + om0 * s0); run1 += __builtin_amdgcn_logf(lb1 + om1 * s1);
            cs0[i] = run0; cs1[i] = run1; kk0[i] = om0 * e0 * s0; kk1[i] = om1 * e1 * s1;
        }
        *(LAS f32x2*)(QT + tg * 128 + 2 * k2) = (f32x2){run0, run1};
        HG_BAR_L();
        {
            f32x2 g[8];
#pragma unroll
            for (int j = 0; j < 8; ++j) g[j] = *(LAS const f32x2*)(QT + j * 128 + 2 * k2);
            f32x2 off = (f32x2){0.f, 0.f};
#pragma unroll
            for (int j = 0; j < 7; ++j) if (j < tg) off += g[j];
            const f32x2 b15 = g[0] + g[1], b31 = b15 + (g[2] + g[3]), b47 = b31 + (g[4] + g[5]);
            const f32x2 bm = th ? b47 : b15;
            const float em0 = __builtin_amdgcn_exp2f(bm[0]), em1 = __builtin_amdgcn_exp2f(bm[1]);
            const float x30 = __builtin_amdgcn_exp2f(th ? (bm[0] - b31[0]) : (b31[0] - bm[0])), x31 = __builtin_amdgcn_exp2f(th ? (bm[1] - b31[1]) : (b31[1] - bm[1]));
#pragma unroll
            for (int i = 0; i < 8; ++i) {
                const int t = 8 * tg + i;
                const float q0 = bflo(qv[i]), q1 = bfhi(qv[i]);
                const float E0 = __builtin_amdgcn_exp2f(off[0] + cs0[i] - bm[0]), E1 = __builtin_amdgcn_exp2f(off[1] + cs1[i] - bm[1]);
                const float R0 = __builtin_amdgcn_rcpf(E0), R1 = __builtin_amdgcn_rcpf(E1);
                const float qm0 = q0 * E0, qm1 = q1 * E1, km0 = kk0[i] * R0, km1 = kk1[i] * R1;
                *(LAS unsigned*)(lds + OQM + t * QROW + k2 * 4) = cvt_pk_bf16(qm0, qm1);
                *(LAS unsigned*)(lds + OKM + t * QROW + k2 * 4) = cvt_pk_bf16(km0, km1);
                *(LAS unsigned*)(lds + OQD + t * QROW + k2 * 4) = cvt_pk_bf16(qm0 * em0, qm1 * em1);
                if (th) *(LAS unsigned*)(lds + OQO + (t - 32) * QROW + k2 * 4) = cvt_pk_bf16(qm0 * x30, qm1 * x31);
                else *(LAS unsigned*)(lds + OKO + t * QROW + k2 * 4) = cvt_pk_bf16(km0 * x30, km1 * x31);
            }
        }
        if (nxt < 2048) HO_LOAD_FQ(nxt);
#pragma unroll
        for (int j = 0; j < 4; ++j) { const int id = tid + 512 * j; *(LAS u32x4*)(lds + OVT + (id >> 5) * VROW + (id & 31) * 16) = vr[j]; }
        if (nxt < 2048) HO_LOAD_V(nxt);
        { const bf16_t* gp_ = GS + ((size_t)(row0 + (tid >> 3))) * 4096 + h * 256 + (tid & 7) * 32;
#pragma unroll
          for (int j = 0; j < 4; ++j) gsr[j] = *(const u32x4*)(gp_ + 8 * j); }
        HG_BAR_L();
        if (wave < 3) {
            const int abase = (wave == 2 ? OQO : OQM) + (wave == 1 ? 32 * QROW : 0), bbase = (wave == 2 ? OKO : OKM) + (wave == 1 ? 32 * QROW : 0);
            LAS const unsigned char* ap = lds + abase + r32 * QROW + hi * 16; LAS const unsigned char* bp = lds + bbase + r32 * QROW + hi * 16;
            f32x16 pc;
#pragma unroll
            for (int r = 0; r < 16; ++r) pc[r] = 0.f;
#pragma unroll
            for (int s = 0; s < 8; ++s) pc = __builtin_amdgcn_mfma_f32_32x32x16_bf16(*(LAS const bf16x8*)(ap + 32 * s), *(LAS const bf16x8*)(bp + 32 * s), pc, 0, 0, 0);
            const int tb = (wave == 0 ? 0 : 32), sb = (wave == 1 ? 32 : 0);
#pragma unroll
            for (int r = 0; r < 16; ++r) { const int tl = (r & 3) + 8 * (r >> 2) + 4 * hi; float v = pc[r]; if (wave < 2 && r32 > tl) v = 0.f;
                *(LAS bf16_t*)(lds + OPS + (tb + tl) * PROW + (sb + r32) * 2) = f2bf(v); }
        }
        HG_BAR_L();
        f32x16 a0, a1;
#pragma unroll
        for (int r = 0; r < 16; ++r) { a0[r] = 0.f; a1[r] = 0.f; }
        {
            LAS const unsigned char* qp = lds + OQD + r32 * QROW + hi * 16;
#pragma unroll
            for (int s = 0; s < 8; ++s) {
                a0 = __builtin_amdgcn_mfma_f32_32x32x16_bf16(*(LAS const bf16x8*)(qp + 32 * s), sfr[s], a0, 0, 0, 0);
                a1 = __builtin_amdgcn_mfma_f32_32x32x16_bf16(*(LAS const bf16x8*)(qp + 32 * QROW + 32 * s), sfr[s], a1, 0, 0, 0);
            }
            LAS const unsigned char* vp = lds + OVT + (8 * hi + (i16 >> 2)) * VROW + (32 * wave + 16 * g1 + 4 * (i16 & 3)) * 2;
            LAS const unsigned char* pp = lds + OPS + r32 * PROW + hi * 16;
#pragma unroll
            for (int st = 0; st < 4; ++st) {
                const s16x4 v0 = tr_read(vp + st * 16 * VROW), v1 = tr_read(vp + st * 16 * VROW + 4 * VROW);
                const bf16x8 vf = (bf16x8){v0[0], v0[1], v0[2], v0[3], v1[0], v1[1], v1[2], v1[3]};
                if (st < 2) a0 = __builtin_amdgcn_mfma_f32_32x32x16_bf16(*(LAS const bf16x8*)(pp + 32 * st), vf, a0, 0, 0, 0);
                a1 = __builtin_amdgcn_mfma_f32_32x32x16_bf16(*(LAS const bf16x8*)(pp + 32 * PROW + 32 * st), vf, a1, 0, 0, 0);
            }
        }
        if (nxt < 2048) HO_LOAD_S(nxt);
        HG_BAR_L();
#pragma unroll
        for (int r = 0; r < 16; ++r) { const int tl = (r & 3) + 8 * (r >> 2) + 4 * hi;
            *(LAS float*)(lds + tl * OROW + (32 * wave + r32) * 4) = a0[r]; *(LAS float*)(lds + (32 + tl) * OROW + (32 * wave + r32) * 4) = a1[r]; }
        HG_BAR_L();
        {
            const int t = tid >> 3, seg = tid & 7;
            f32x4 ov[8]; float ssq = 0.f;
#pragma unroll
            for (int j = 0; j < 8; ++j) { ov[j] = *(LAS const f32x4*)(lds + t * OROW + seg * 128 + j * 16); ssq += (ov[j][0] * ov[j][0] + ov[j][1] * ov[j][1]) + (ov[j][2] * ov[j][2] + ov[j][3] * ov[j][3]); }
            ssq += __shfl_xor(ssq, 1); ssq += __shfl_xor(ssq, 2); ssq += __shfl_xor(ssq, 4);
            const float rs = __builtin_amdgcn_rsqf(ssq * (1.0f / 256.0f) + EPS);
            bf16_t* gp = GS + ((size_t)(row0 + t)) * 4096 + h * 256 + seg * 32;
#pragma unroll
            for (int j = 0; j < 4; ++j) {
                const u32x4 g = gsr[j]; const f32x4 n0 = gnr[2 * j], n1 = gnr[2 * j + 1]; const f32x4 x0 = ov[2 * j] * rs * n0, x1 = ov[2 * j + 1] * rs * n1;
                u32x4 w; w.x = cvt_pk_bf16(x0[0] * bflo(g.x), x0[1] * bfhi(g.x)); w.y = cvt_pk_bf16(x0[2] * bflo(g.y), x0[3] * bfhi(g.y));
                w.z = cvt_pk_bf16(x1[0] * bflo(g.z), x1[1] * bfhi(g.z)); w.w = cvt_pk_bf16(x1[2] * bflo(g.w), x1[3] * bfhi(g.w));
                if (do_store) *(u32x4*)(gp + 8 * j) = w;
            }
        }
    }
    HG_BAR_L();
#undef HO_LOAD_FQ
#undef HO_LOAD_V
#undef HO_LOAD_S
}

__device__ __forceinline__ float dot2(unsigned a, unsigned b) { return bflo(a) * bflo(b) + bfhi(a) * bfhi(b); }
__device__ __forceinline__ void attn_naive(const Params& p, int gw, int NGW, int lane) {
    const bf16_t* Q = (const bf16_t*)(p.ws + WS_Q); const bf16_t* KN = (const bf16_t*)(p.ws + WS_KN); const bf16_t* KR = (const bf16_t*)(p.ws + WS_KR);
    const bf16_t* V = (const bf16_t*)(p.ws + WS_V); bf16_t* GATE = (bf16_t*)(p.ws + WS_GATE);
    for (int unit = gw; unit < 16384; unit += NGW) {
        const int quar = unit & 3, qblk = (unit >> 2) & 31, bh = unit >> 7, b = bh >> 5, h = bh & 31;
        const int qi = qblk * 64 + lane;
        unsigned qr[96];
        { const u32x4* qp = (const u32x4*)(Q + ((size_t)(bh * 2048 + qi)) * 192);
#pragma unroll
          for (int i = 0; i < 24; ++i) { const u32x4 t = qp[i]; qr[4 * i] = t.x; qr[4 * i + 1] = t.y; qr[4 * i + 2] = t.z; qr[4 * i + 3] = t.w; } }
        float o[32];
#pragma unroll
        for (int d = 0; d < 32; ++d) o[d] = 0.f;
        float mx = -1e30f, l = 0.f;
        const int jmax = qblk * 64 + 63;
        for (int j = 0; j <= jmax; ++j) {
            const u32x4* kp = (const u32x4*)(KN + ((size_t)(bh * 2048 + j)) * 128);
            const u32x4* rp = (const u32x4*)(KR + ((size_t)(b * 2048 + j)) * 64);
            float s = 0.f;
#pragma unroll
            for (int i = 0; i < 96; ++i) asm volatile("" : "+v"(qr[i]));
#pragma unroll
            for (int i = 0; i < 16; ++i) { const u32x4 kv = kp[i]; s += dot2(qr[4 * i], kv.x) + dot2(qr[4 * i + 1], kv.y) + dot2(qr[4 * i + 2], kv.z) + dot2(qr[4 * i + 3], kv.w); if ((i & 3) == 3) asm volatile("" ::: "memory"); }
#pragma unroll
            for (int i = 0; i < 8; ++i) { const u32x4 kv = rp[i]; s += dot2(qr[64 + 4 * i], kv.x) + dot2(qr[64 + 4 * i + 1], kv.y) + dot2(qr[64 + 4 * i + 2], kv.z) + dot2(qr[64 + 4 * i + 3], kv.w); if ((i & 3) == 3) asm volatile("" ::: "memory"); }
            if (j <= qi) {
                if (s > mx) { const float al = __builtin_amdgcn_exp2f(mx - s); l *= al;
#pragma unroll
                    for (int d = 0; d < 32; ++d) o[d] *= al;
                    mx = s; }
                const float pe = __builtin_amdgcn_exp2f(s - mx); l += pe;
                const u32x4* vp = (const u32x4*)(V + ((size_t)(bh * 2048 + j)) * 128 + quar * 32);
#pragma unroll
                for (int i = 0; i < 4; ++i) { const u32x4 vv = vp[i];
                    o[8 * i] += pe * bflo(vv.x); o[8 * i + 1] += pe * bfhi(vv.x); o[8 * i + 2] += pe * bflo(vv.y); o[8 * i + 3] += pe * bfhi(vv.y);
                    o[8 * i + 4] += pe * bflo(vv.z); o[8 * i + 5] += pe * bfhi(vv.z); o[8 * i + 6] += pe * bflo(vv.w); o[8 * i + 7] += pe * bfhi(vv.w); }
            }
        }
        const float il = 1.0f / l;
        u32x4* gp = (u32x4*)(GATE + ((size_t)(b * 2048 + qi)) * 4096 + h * 128 + quar * 32);
#pragma unroll
        for (int i = 0; i < 4; ++i) { const u32x4 g = gp[i]; u32x4 w;
            w.x = cvt_pk_bf16(o[8 * i] * il * bflo(g.x), o[8 * i + 1] * il * bfhi(g.x)); w.y = cvt_pk_bf16(o[8 * i + 2] * il * bflo(g.y), o[8 * i + 3] * il * bfhi(g.y));
            w.z = cvt_pk_bf16(o[8 * i + 4] * il * bflo(g.z), o[8 * i + 5] * il * bfhi(g.z)); w.w = cvt_pk_bf16(o[8 * i + 6] * il * bflo(g.w), o[8 * i + 7] * il * bfhi(g.w));
            gp[i] = w; }
    }
}

constexpr int AT_KROW = 400, AT_VROW = 320, AT_KB = 64 * AT_KROW, AT_VB = 64 * AT_VROW, AT_STAGE = AT_KB + AT_VB, AT_WSF = 2 * AT_STAGE;
__device__ __forceinline__ void attn_unit(int bh, int qb, const bf16_t* __restrict__ Q, const bf16_t* __restrict__ KN, const bf16_t* __restrict__ KR, const bf16_t* __restrict__ V, bf16_t* GATE,
                                          LAS unsigned char* lds, int tid, int wave, int lane, int do_store) {
    const int r32 = lane & 31, hi = lane >> 5, b = bh >> 5, h = bh & 31;
    const int q0 = qb * 256, NT = 4 * (qb + 1);
    LAS float* wsf = (LAS float*)(lds + AT_WSF) + wave * 32;
    const int krow = tid >> 4, kc = tid & 15, rrow = tid >> 3, rc = tid & 7;
    const bf16_t* kn_src = KN + ((size_t)(bh * 2048 + krow)) * 128 + kc * 8;
    const bf16_t* kr_src = KR + ((size_t)(b * 2048 + rrow)) * 64 + rc * 8;
    const bf16_t* v_src = V + ((size_t)(bh * 2048 + krow)) * 128 + kc * 8;
    const int kn_dst = krow * AT_KROW + kc * 16, kr_dst = rrow * AT_KROW + 256 + rc * 16, v_dst = AT_KB + krow * AT_VROW + kc * 16;
    u32x4 sk0, sk1, skr, sv0, sv1;
#define AT_LOAD(t) do { const size_t o_ = (size_t)(t) * 64 * 128; sk0 = *(const u32x4*)(kn_src + o_); sk1 = *(const u32x4*)(kn_src + o_ + 32 * 128); skr = *(const u32x4*)(kr_src + (size_t)(t) * 64 * 64); \
        sv0 = *(const u32x4*)(v_src + o_); sv1 = *(const u32x4*)(v_src + o_ + 32 * 128); } while (0)
#define AT_WRITE(bufoff) do { LAS unsigned char* d_ = lds + (bufoff); *(LAS u32x4*)(d_ + kn_dst) = sk0; *(LAS u32x4*)(d_ + kn_dst + 32 * AT_KROW) = sk1; *(LAS u32x4*)(d_ + kr_dst) = skr; \
        *(LAS u32x4*)(d_ + v_dst) = sv0; *(LAS u32x4*)(d_ + v_dst + 32 * AT_VROW) = sv1; } while (0)
    AT_LOAD(0);
    bf16x8 qf[12];
    { const bf16_t* qrow = Q + ((size_t)(bh * 2048 + q0 + wave * 32 + r32)) * 192 + hi * 8;
#pragma unroll
      for (int k = 0; k < 12; ++k) qf[k] = *(const bf16x8*)(qrow + 16 * k); }
    f32x16 o[4];
#pragma unroll
    for (int d = 0; d < 4; ++d)
#pragma unroll
        for (int r = 0; r < 16; ++r) o[d][r] = 0.f;
    float mrun = -1e30f, lrun = 0.f;
    AT_WRITE(0);
    if (NT > 1) AT_LOAD(1);
    asm volatile("s_waitcnt lgkmcnt(0)" ::: "memory"); __builtin_amdgcn_s_barrier(); asm volatile("" ::: "memory");
    const int ka_off = r32 * AT_KROW + hi * 16;
    const int i16 = lane & 15, g1 = (lane >> 4) & 1;
    const int va_off = AT_KB + (4 * hi + (i16 >> 2)) * AT_VROW + (16 * g1 + 4 * (i16 & 3)) * 2;
    const int qloc = 32 * wave + r32;
    for (int t = 0; t < NT; ++t) {
        const int cur = (t & 1) * AT_STAGE;
        const int kvrel = 64 * t - q0;
        if (kvrel <= 32 * wave + 31) {
            LAS const unsigned char* kp = lds + cur + ka_off;
            f32x16 p0, p1;
#pragma unroll
            for (int r = 0; r < 16; ++r) { p0[r] = 0.f; p1[r] = 0.f; }
#pragma unroll
            for (int k = 0; k < 12; ++k) {
                const bf16x8 a0 = *(LAS const bf16x8*)(kp + k * 32), a1 = *(LAS const bf16x8*)(kp + 32 * AT_KROW + k * 32);
                p0 = __builtin_amdgcn_mfma_f32_32x32x16_bf16(a0, qf[k], p0, 0, 0, 0);
                p1 = __builtin_amdgcn_mfma_f32_32x32x16_bf16(a1, qf[k], p1, 0, 0, 0);
                if ((k % 3) == 2) asm volatile("" ::: "memory");
            }
            if (kvrel + 63 > 32 * wave) {
#pragma unroll
                for (int r = 0; r < 16; ++r) { const int kv = kvrel + (r & 3) + 8 * (r >> 2) + 4 * hi;
                    if (kv > qloc) p0[r] = -INFINITY; if (kv + 32 > qloc) p1[r] = -INFINITY; }
            }
            float rm = fmaxf(p0[0], p1[0]);
#pragma unroll
            for (int r = 1; r < 16; ++r) rm = fmaxf(rm, fmaxf(p0[r], p1[r]));
            rm = fmaxf(rm, __shfl_xor(rm, 32));
            if (__any(rm > mrun + 8.0f)) {
                const float mn = fmaxf(mrun, rm), al = __builtin_amdgcn_exp2f(mrun - mn);
                mrun = mn; lrun *= al;
                if (hi == 0) wsf[r32] = al;
                asm volatile("s_waitcnt lgkmcnt(0)" ::: "memory");
#pragma unroll
                for (int g = 0; g < 4; ++g) { const f32x4 a4 = *(LAS const f32x4*)(wsf + 8 * g + 4 * hi);
#pragma unroll
                    for (int d = 0; d < 4; ++d) { o[d][4 * g] *= a4[0]; o[d][4 * g + 1] *= a4[1]; o[d][4 * g + 2] *= a4[2]; o[d][4 * g + 3] *= a4[3]; } }
            }
            float ls = 0.f;
#pragma unroll
            for (int r = 0; r < 16; ++r) { p0[r] = __builtin_amdgcn_exp2f(p0[r] - mrun); p1[r] = __builtin_amdgcn_exp2f(p1[r] - mrun); ls += p0[r] + p1[r]; }
            lrun += ls;
            bf16x8 pa[4];
#pragma unroll
            for (int s2 = 0; s2 < 2; ++s2) {
                u32x4 w0, w1;
                w0.x = cvt_pk_bf16(p0[8 * s2], p0[8 * s2 + 1]); w0.y = cvt_pk_bf16(p0[8 * s2 + 2], p0[8 * s2 + 3]); w0.z = cvt_pk_bf16(p0[8 * s2 + 4], p0[8 * s2 + 5]); w0.w = cvt_pk_bf16(p0[8 * s2 + 6], p0[8 * s2 + 7]);
                w1.x = cvt_pk_bf16(p1[8 * s2], p1[8 * s2 + 1]); w1.y = cvt_pk_bf16(p1[8 * s2 + 2], p1[8 * s2 + 3]); w1.z = cvt_pk_bf16(p1[8 * s2 + 4], p1[8 * s2 + 5]); w1.w = cvt_pk_bf16(p1[8 * s2 + 6], p1[8 * s2 + 7]);
                pa[s2] = __builtin_bit_cast(bf16x8, w0); pa[2 + s2] = __builtin_bit_cast(bf16x8, w1);
            }
            LAS const unsigned char* vp = lds + cur + va_off;
#pragma unroll
            for (int s = 0; s < 4; ++s) {
                const int rb = (16 * (s & 1) + 32 * (s >> 1)) * AT_VROW;
#pragma unroll
                for (int d = 0; d < 4; ++d) {
                    const s16x4 lo = tr_read(vp + rb + d * 64), hh = tr_read(vp + rb + 8 * AT_VROW + d * 64);
                    const bf16x8 vf = (bf16x8){lo[0], lo[1], lo[2], lo[3], hh[0], hh[1], hh[2], hh[3]};
                    o[d] = __builtin_amdgcn_mfma_f32_32x32x16_bf16(pa[s], vf, o[d], 0, 0, 0);
                }
                asm volatile("" ::: "memory");
            }
        }
        if (t + 1 < NT) AT_WRITE(((t + 1) & 1) * AT_STAGE);
        asm volatile("s_waitcnt lgkmcnt(0)" ::: "memory"); __builtin_amdgcn_s_barrier(); asm volatile("" ::: "memory");
        if (t + 2 < NT) AT_LOAD(t + 2);
    }
    lrun += __shfl_xor(lrun, 32);
    if (hi == 0) wsf[r32] = 1.0f / lrun;
    asm volatile("s_waitcnt lgkmcnt(0)" ::: "memory");
#pragma unroll
    for (int g = 0; g < 4; ++g) {
        const f32x4 li = *(LAS const f32x4*)(wsf + 8 * g + 4 * hi);
#pragma unroll
        for (int i = 0; i < 4; ++i) {
            const int row = q0 + 32 * wave + 8 * g + 4 * hi + i;
            bf16_t* gp = GATE + ((size_t)(b * 2048 + row)) * 4096 + h * 128 + r32;
#pragma unroll
            for (int d = 0; d < 4; ++d) { const float y = o[d][4 * g + i] * li[i] * bf2f(gp[32 * d]); if (do_store) gp[32 * d] = (bf16_t)(cvt_pk_bf16(y, 0.f) & 0xffffu); }
        }
    }
#undef AT_LOAD
#undef AT_WRITE
}
__device__ __forceinline__ void attn_phase(const Params& p, LAS unsigned char* lds, int tid, int wave, int lane, int do_store) {
    const bf16_t* Q = (const bf16_t*)(p.ws + WS_Q); const bf16_t* KN = (const bf16_t*)(p.ws + WS_KN); const bf16_t* KR = (const bf16_t*)(p.ws + WS_KR);
    const bf16_t* V = (const bf16_t*)(p.ws + WS_V); bf16_t* GATE = (bf16_t*)(p.ws + WS_GATE);
    for (int pi = blockIdx.x; pi < 512; pi += gridDim.x) {
        const int bh = pi >> 2, pp = pi & 3;
        attn_unit(bh, 7 - pp, Q, KN, KR, V, GATE, lds, tid, wave, lane, do_store);
        attn_unit(bh, pp, Q, KN, KR, V, GATE, lds, tid, wave, lane, do_store);
    }
}

__device__ __forceinline__ void final_norm(const Params& p, int gw, int NGW, int lane) {
    const float* ss2 = (const float*)(p.ws + WS_SS2);
    for (int m = gw; m < NTOK; m += NGW) {
        const float t = wave_sum(lane < 32 ? ss2[(size_t)m * 32 + lane] : 0.f);
        const float rs = __builtin_amdgcn_rsqf(t * (1.0f / 2048.0f) + EPS);
        f32x4* xr = (f32x4*)(p.out + (size_t)m * 2048) + lane; const f32x4* gr = (const f32x4*)p.final_norm_g + lane;
#pragma unroll
        for (int j = 0; j < 8; ++j) { const f32x4 v = xr[64 * j], g = gr[64 * j]; xr[64 * j] = v * rs * g; }
    }
}

__global__ void __launch_bounds__(512) yoco_fwd(Params p) {
    extern __shared__ __attribute__((aligned(16))) unsigned char lds_raw[];
    LAS unsigned char* lds = (LAS unsigned char*)lds_raw;
    cg::grid_group grid = cg::this_grid();
    { volatile LAS unsigned* m_ = (volatile LAS unsigned*)(lds + 147200); if (threadIdx.x < 32) m_[threadIdx.x] = 0u; }
    __syncthreads();
    XcdBarrier xbar = xcd_barrier_post((unsigned*)p.ws + 4096, (volatile LAS unsigned*)(lds + 147200) + 8);
    const int wave = __builtin_amdgcn_readfirstlane(threadIdx.x >> 6);
    const int G = gridDim.x, gw = blockIdx.x * 8 + wave, NGW = G * 8;
    unsigned char* ws = p.ws;
    for (int rep = 0; rep < R_SYNC; ++rep) grid.sync();
    for (int rep = 0; rep < R_P0; ++rep) phase0(p, lds, wave, pg8::pg8_lane_id(), gw, NGW);
    if (p.ws == nullptr) grid.sync();
    xcd_barrier(xbar);
    for (int rep = 0; rep < R_G1; ++rep)
    { pg8::Gemm g{(const bf16_t*)(ws + WS_XN), (const bf16_t*)(ws + WS_W1T), NTOK, 12288, 2048}; pg8::StaticOrder S; S.init(NTOK, 12288, G, (int)blockIdx.x);
      EpiRep<EpiG1> E{{(bf16_t*)(ws + WS_QH), p.out, (bf16_t*)(ws + WS_VI), (bf16_t*)(ws + WS_GS)}};
      pg8::gemm_phase<EpiRep<EpiG1>, pg8::StaticOrder, PG8_ALIGN, PG8_SP2>(lds, g, S, E, wave); }
    xcd_barrier(xbar);
    for (int rep = 0; rep < R_HG * R_HGS; ++rep) { const int l_ = pg8::pg8_lane_id(); hgrn_state_phase(p, lds, wave * 64 + l_, wave, l_); }
    xcd_barrier(xbar);
    for (int rep = 0; rep < R_HG; ++rep) { const int l_ = pg8::pg8_lane_id(); hgrn_out_phase(p, lds, wave * 64 + l_, wave, l_, rep == R_HG - 1); }
    xcd_barrier(xbar);
    { pg8::Gemm g{(const bf16_t*)(ws + WS_GS), (const bf16_t*)(ws + WS_W2T), NTOK, 2048, 4096}; pg8::StaticOrder S; S.init(NTOK, 2048, G, (int)blockIdx.x);
      EpiRes<true> E{p.x, p.out, (bf16_t*)(ws + WS_H1B), (float*)(ws + WS_SS1)};
      pg8::gemm_phase<EpiRes<true>, pg8::StaticOrder, PG8_ALIGN, PG8_SP2>(lds, g, S, E, wave); }
    xcd_barrier(xbar);
    for (int rep = 0; rep < R_G3; ++rep)
    { pg8::Gemm g{(const bf16_t*)(ws + WS_H1B), (const bf16_t*)(ws + WS_W3T), NTOK, 5632, 2048}; pg8::StaticOrder S; S.init(NTOK, 5632, G, (int)blockIdx.x);
      EpiG3 E{(const float*)(ws + WS_SS1), (bf16_t*)(ws + WS_CQ), (bf16_t*)(ws + WS_GATE), (bf16_t*)(ws + WS_C), (bf16_t*)(ws + WS_KR), (float*)(ws + WS_SSQ), (float*)(ws + WS_SSC)};
      pg8::gemm_phase<EpiG3, pg8::StaticOrder, PG8_ALIGN, PG8_SP2>(lds, g, S, E, wave); }
    xcd_barrier(xbar);
    for (int rep = 0; rep < R_G45; ++rep) {
    { pg8::Gemm g{(const bf16_t*)(ws + WS_CQ), (const bf16_t*)(ws + WS_W4T), NTOK, 6144, 768}; pg8::StaticOrder S; S.init(NTOK, 6144, G, (int)blockIdx.x);
      EpiQ E{(const float*)(ws + WS_SSQ), (bf16_t*)(ws + WS_Q)};
      pg8::gemm_phase<EpiQ, pg8::StaticOrder, PG8_ALIGN, PG8_SP2>(lds, g, S, E, wave); }
    { pg8::Gemm g{(const bf16_t*)(ws + WS_C), (const bf16_t*)(ws + WS_W5T), NTOK, 8192, 512}; pg8::StaticOrder S; S.init(NTOK, 8192, G, (int)blockIdx.x);
      EpiKV E{(const float*)(ws + WS_SSC), (bf16_t*)(ws + WS_KN), (bf16_t*)(ws + WS_V)};
      pg8::gemm_phase<EpiKV, pg8::StaticOrder, PG8_ALIGN, PG8_SP2>(lds, g, S, E, wave); }
    }
    xcd_barrier(xbar);
    for (int rep = 0; rep < R_AT; ++rep) { const int l_ = pg8::pg8_lane_id(); attn_phase(p, lds, wave * 64 + l_, wave, l_, rep == R_AT - 1); }
    xcd_barrier(xbar);
    { pg8::Gemm g{(const bf16_t*)(ws + WS_GATE), (const bf16_t*)(ws + WS_W6T), NTOK, 2048, 4096}; pg8::StaticOrder S; S.init(NTOK, 2048, G, (int)blockIdx.x);
      EpiRes<false> E{p.out, p.out, nullptr, (float*)(ws + WS_SS2)};
      pg8::gemm_phase<EpiRes<false>, pg8::StaticOrder, PG8_ALIGN, PG8_SP2>(lds, g, S, E, wave); }
    xcd_barrier(xbar);
    final_norm(p, gw, NGW, pg8::pg8_lane_id());
}

extern "C" void kernel_launch(void* const* d_in, const int* in_sizes, int n_in, void* d_out, int out_size, void* d_ws, size_t ws_size, hipStream_t stream) {
    static int grid = 0;
    if (grid == 0) {
        if (n_in != 15 || out_size != NTOK * DM || ws_size < WS_NEED) { fprintf(stderr, "kernel_launch: unexpected shapes (n_in %d out %d ws %zu)\n", n_in, out_size, ws_size); grid = -1; return; }
        int dev = 0, cus = 0, per_cu = 0;
        hipGetDevice(&dev); hipDeviceGetAttribute(&cus, hipDeviceAttributeMultiprocessorCount, dev);
        hipFuncSetAttribute((const void*)yoco_fwd, hipFuncAttributeMaxDynamicSharedMemorySize, LDS_BYTES);
        hipOccupancyMaxActiveBlocksPerMultiprocessor(&per_cu, (const void*)yoco_fwd, 512, LDS_BYTES);
        if (per_cu < 1) per_cu = 1;
        (void)hipGetLastError();
        grid = cus * per_cu;
    }
    if (grid < 0) return;
    Params p{};
    p.x = (const float*)d_in[0]; p.norm_g = (const float*)d_in[1]; p.hg_w_in = (const float*)d_in[2]; p.hg_g_norm = (const float*)d_in[3]; p.hg_w_out = (const float*)d_in[4];
    p.hg_lb = (const float*)d_in[5]; p.kv_in_norm_g = (const float*)d_in[6]; p.w_kv_down = (const float*)d_in[7]; p.kv_norm_g = (const float*)d_in[8]; p.w_kv_up = (const float*)d_in[9];
    p.mla_w_in = (const float*)d_in[10]; p.mla_q_norm_g = (const float*)d_in[11]; p.mla_w_q_up = (const float*)d_in[12]; p.mla_w_out = (const float*)d_in[13]; p.final_norm_g = (const float*)d_in[14];
    p.out = (float*)d_out; p.ws = (unsigned char*)d_ws;
    if (hipMemsetAsync(d_ws, 0, 65536, stream) != hipSuccess) { fprintf(stderr, "memset failed\n"); return; }
    void* args[] = {&p};
    hipError_t e = hipLaunchCooperativeKernel((const void*)yoco_fwd, dim3(grid), dim3(512), args, LDS_BYTES, stream);
    if (e != hipSuccess) fprintf(stderr, "cooperative launch failed: %s (grid %d)\n", hipGetErrorString(e), grid);
}
```
